# Optimizing an MI355X kernel written in HIP

```python
import jax, jax.numpy as jnp
from jax import lax
import numpy as np

D_MODEL = 2048
BATCH = 4
SEQ = 4096
DEPTH = 2

HEAD_DIM = 128
HA = 8
GA = 2
RA = HA // GA
HB = 8
WIN = 128
BLK = 128
GRID_W = 64
NA_KH = 8
NA_KW = 16
ROT_DIM = HEAD_DIM // 4
ROPE_THETA = 500000.0
D_FF = 5632
CONV_W = 3
EPS = 1e-6
NEG_INF = -1e30
QA_W = HA * HEAD_DIM
KA_W = GA * HEAD_DIM
QB_W = HB * HEAD_DIM
IN_SIZES = (QA_W, KA_W, KA_W, QB_W, QB_W, QB_W, D_MODEL, D_MODEL)
IN_COLS = QA_W + 2 * KA_W + 3 * QB_W + 2 * D_MODEL

kernel_name = "hybrid_window_gqa_neighbourhood_convffn_adaln"


def rmsnorm(x, g):
    xf = x.astype(jnp.float32)
    y = xf * lax.rsqrt(jnp.mean(xf * xf, axis=-1, keepdims=True) + EPS)
    return (y * g.astype(jnp.float32)).astype(x.dtype)


def split_cols(p):
    pts, acc = [], 0
    for s in IN_SIZES[:-1]:
        acc += s
        pts.append(acc)
    return jnp.split(p, pts, axis=-1)


def rotary_partial(x, pos):
    half = ROT_DIM // 2
    inv = jnp.float32(ROPE_THETA) ** (-jnp.arange(0, ROT_DIM, 2, dtype=jnp.float32) / ROT_DIM)
    ang = pos[:, None] * inv[None, :]
    cos = jnp.cos(ang)[None, :, None, :].astype(x.dtype)
    sin = jnp.sin(ang)[None, :, None, :].astype(x.dtype)
    x1, x2, xp = x[..., :half], x[..., half:ROT_DIM], x[..., ROT_DIM:]
    return jnp.concatenate([x1 * cos - x2 * sin, x2 * cos + x1 * sin, xp], axis=-1)


def window_attention(q, k, v, sink):
    B, S = q.shape[0], q.shape[1]
    nb = S // BLK
    qb = q.astype(jnp.float32).reshape(B, nb, BLK, GA, RA, HEAD_DIM)

    def band(t):
        tp = jnp.pad(t.astype(jnp.float32), ((0, 0), (BLK, BLK), (0, 0), (0, 0)))
        tp = tp.reshape(B, nb + 2, BLK, GA, HEAD_DIM)
        return jnp.concatenate([tp[:, :-2], tp[:, 1:-1], tp[:, 2:]], axis=2)

    kw, vw = band(k), band(v)
    qi = jnp.arange(BLK)
    ki = jnp.arange(3 * BLK) - BLK
    rel = ki[None, :] - qi[:, None]
    kpos = jnp.arange(nb)[:, None] * BLK + ki[None, :]
    mask = (jnp.abs(rel) <= WIN)[None] & ((kpos >= 0) & (kpos < S))[:, None, :]
    s = jnp.einsum('bnqgrd,bnkgd->bgrnqk', qb, kw) * (HEAD_DIM ** -0.5)
    s = jnp.where(mask[None, None, None], s, NEG_INF)
    snk = sink.astype(jnp.float32).reshape(GA, RA)[None, :, :, None, None, None]
    m = jnp.maximum(jnp.max(s, axis=-1, keepdims=True), snk)
    p = jnp.exp(s - m)
    p = p / (jnp.sum(p, axis=-1, keepdims=True) + jnp.exp(snk - m))
    o = jnp.einsum('bgrnqk,bnkgd->bnqgrd', p, vw)
    return o.reshape(B, S, HA * HEAD_DIM).astype(q.dtype)


def neighbourhood_attention(q, k, v, bias_tab):
    B, S = q.shape[0], q.shape[1]
    rows = S // GRID_W
    kh = min(NA_KH, rows)
    r = jnp.arange(rows)
    row_start = jnp.clip(r - kh // 2, 0, rows - kh)
    key_rows = row_start[:, None] + jnp.arange(kh)[None, :]
    qg = q.astype(jnp.float32).reshape(B, rows, GRID_W, HB, HEAD_DIM)
    kg = k.astype(jnp.float32).reshape(B, rows, GRID_W, HB, HEAD_DIM)[:, key_rows]
    vg = v.astype(jnp.float32).reshape(B, rows, GRID_W, HB, HEAD_DIM)[:, key_rows]
    s = jnp.einsum('brqhd,brikhd->bhrqik', qg, kg) * (HEAD_DIM ** -0.5)
    col = jnp.arange(GRID_W)
    col_start = jnp.clip(col - NA_KW // 2, 0, GRID_W - NA_KW)
    col_mask = (col[None, :] >= col_start[:, None]) & (col[None, :] < col_start[:, None] + NA_KW)
    dr_idx = key_rows - r[:, None] + (NA_KH - 1)
    dc_idx = jnp.clip(col[None, :] - col[:, None] + (NA_KW - 1), 0, 2 * NA_KW - 2)
    bias = bias_tab.astype(jnp.float32)[:, dr_idx[:, None, :, None], dc_idx[None, :, None, :]]
    s = jnp.where(col_mask[None, None, None, :, None, :], s + bias[None], NEG_INF)
    p = jax.nn.softmax(s.reshape(B, HB, rows, GRID_W, kh * GRID_W), axis=-1)
    p = p.reshape(B, HB, rows, GRID_W, kh, GRID_W)
    o = jnp.einsum('bhrqik,brikhd->brqhd', p, vg)
    return o.reshape(B, S, HB * HEAD_DIM).astype(q.dtype)


def depthwise_conv(u, w, b):
    up = jnp.pad(u, ((0, 0), (1, 1), (0, 0)))
    return up[:, :-2] * w[0] + up[:, 1:-1] * w[1] + up[:, 2:] * w[2] + b


def setup_inputs(seed: int = 0) -> dict:
    key = jax.random.key(seed)
    ks = jax.random.split(key, 22)

    def nrm(k, shape, scale):
        return jax.random.normal(k, shape, jnp.float32) * scale

    L, D = DEPTH, D_MODEL
    return {
        "x": nrm(ks[0], (BATCH, SEQ, D), 1.0),
        "c": nrm(ks[1], (BATCH, D), 1.0),
        "ada_w": nrm(ks[2], (L, D, 6 * D), 0.5 * D ** -0.5),
        "ada_b": nrm(ks[3], (L, 6 * D), 0.02),
        "norm_mix": 1.0 + nrm(ks[4], (L, D), 0.05),
        "norm_ffn": 1.0 + nrm(ks[5], (L, D), 0.05),
        "w_in": nrm(ks[6], (L, D, IN_COLS), D ** -0.5),
        "qn_a": 1.0 + nrm(ks[7], (L, HEAD_DIM), 0.05),
        "kn_a": 1.0 + nrm(ks[8], (L, HEAD_DIM), 0.05),
        "qn_b": 1.0 + nrm(ks[9], (L, HEAD_DIM), 0.05),
        "kn_b": 1.0 + nrm(ks[10], (L, HEAD_DIM), 0.05),
        "sink_a": nrm(ks[11], (L, HA), 1.0),
        "rel_bias_b": nrm(ks[12], (L, HB, 2 * NA_KH - 1, 2 * NA_KW - 1), 0.5),
        "w_proj_a": nrm(ks[13], (L, QA_W, D), QA_W ** -0.5),
        "w_proj_b": nrm(ks[14], (L, QB_W, D), QB_W ** -0.5),
        "w_out": nrm(ks[15], (L, D, D), D ** -0.5),
        "w_up": nrm(ks[16], (L, D, 2 * D_FF), D ** -0.5),
        "conv_w": nrm(ks[17], (L, CONV_W, 2 * D_FF), CONV_W ** -0.5),
        "conv_b": nrm(ks[18], (L, 2 * D_FF), 0.02),
        "w_down": nrm(ks[19], (L, D_FF, D), D_FF ** -0.5),
    }


def reference(x, c, ada_w, ada_b, norm_mix, norm_ffn, w_in, qn_a, kn_a, qn_b, kn_b,
              sink_a, rel_bias_b, w_proj_a, w_proj_b, w_out, w_up, conv_w, conv_b, w_down):
    B, S, _ = x.shape
    pos = jnp.arange(S, dtype=jnp.float32)
    c_act = jax.nn.silu(c)
    for l in range(DEPTH):
        mod = c_act @ ada_w[l] + ada_b[l]
        sh_a, sc_a, gt_a, sh_m, sc_m, gt_m = [t[:, None, :] for t in jnp.split(mod, 6, axis=-1)]

        h = rmsnorm(x, norm_mix[l]) * (1.0 + sc_a) + sh_a
        qa, ka, va, qb, kb, vb, ga, gb = split_cols(h @ w_in[l])
        qa = rotary_partial(rmsnorm(qa.reshape(B, S, HA, HEAD_DIM), qn_a[l]), pos)
        ka = rotary_partial(rmsnorm(ka.reshape(B, S, GA, HEAD_DIM), kn_a[l]), pos)
        va = va.reshape(B, S, GA, HEAD_DIM)
        ya = window_attention(qa, ka, va, sink_a[l]) @ w_proj_a[l]
        qb = rmsnorm(qb.reshape(B, S, HB, HEAD_DIM), qn_b[l])
        kb = rmsnorm(kb.reshape(B, S, HB, HEAD_DIM), kn_b[l])
        vb = vb.reshape(B, S, HB, HEAD_DIM)
        yb = neighbourhood_attention(qb, kb, vb, rel_bias_b[l]) @ w_proj_b[l]
        merged = jax.nn.sigmoid(ga) * ya + jax.nn.sigmoid(gb) * yb
        x = x + gt_a * (merged @ w_out[l])

        h = rmsnorm(x, norm_ffn[l]) * (1.0 + sc_m) + sh_m
        u = depthwise_conv(h @ w_up[l], conv_w[l], conv_b[l])
        g, v = jnp.split(u, 2, axis=-1)
        x = x + gt_m * ((jax.nn.silu(g) * v) @ w_down[l])
    return x
```

```cpp
#include <hip/hip_runtime.h>
#include <hip/hip_cooperative_groups.h>
#include <cstdio>
#include <cstdint>
#include <cmath>
namespace cg = cooperative_groups;

#define LAS __attribute__((address_space(3)))
typedef unsigned short bf16_t;
typedef short bf16x8 __attribute__((ext_vector_type(8)));
typedef float f32x4 __attribute__((ext_vector_type(4)));
typedef float f32x16 __attribute__((ext_vector_type(16)));
typedef unsigned u32x4 __attribute__((ext_vector_type(4)));
typedef unsigned u32x2 __attribute__((ext_vector_type(2)));

constexpr int DM = 2048, NB = 4, SEQ = 4096, MTOK = NB * SEQ;
constexpr int INC = 8704, NMAIN = 7424, NVC = 1280, FF = 5632, FF2 = 11264, MODW = 12288;
constexpr int QKG_LD = NMAIN;
constexpr int VT_LD = MTOK + 128;
constexpr int C_QA = 0, C_KA = 1024, C_QB = 1280, C_KB = 2304, C_SA = 3328, C_SB = 5376;
constexpr float EPS = 1e-6f;
constexpr float LOG2E = 1.4426950408889634f;
constexpr float C2 = 0.08838834764831845f * 1.4426950408889634f;

constexpr size_t MiB = 1u << 20;
constexpr size_t WS_BAR = 0;
constexpr size_t WS_MOD = 1 * MiB;
constexpr size_t WS_NW = 1 * MiB + 512 * 1024;
constexpr size_t WS_ROPEC = 2 * MiB, WS_ROPES = 2 * MiB + 512 * 1024;
constexpr size_t WS_WIN = 4 * MiB;
constexpr size_t WS_WPA = 38 * MiB;
constexpr size_t WS_WPB = 42 * MiB;
constexpr size_t WS_WO = 46 * MiB;
constexpr size_t WS_WUP = 54 * MiB;
constexpr size_t WS_WDN = 98 * MiB;
constexpr size_t WS_H = 120 * MiB;
constexpr size_t WS_QKG = 184 * MiB;
constexpr size_t WS_VT = 416 * MiB;
constexpr size_t WS_OA = 457 * MiB;
constexpr size_t WS_OB = 489 * MiB;
constexpr size_t WS_T1 = 521 * MiB;
constexpr size_t WS_MRG = 585 * MiB;
constexpr size_t WS_HALO = 360 * MiB;
constexpr size_t WS_ACT = 184 * MiB;
constexpr size_t WS_END = 649 * MiB;

constexpr int LDS_BYTES = 147456;
constexpr int XL_OFF = 131072;
constexpr int MISC_OFF = 131072 + 8192;

__device__ __forceinline__ unsigned cvt_pk_bf16(float lo, float hi) { unsigned r; asm volatile("v_cvt_pk_bf16_f32 %0, %1, %2" : "=v"(r) : "v"(lo), "v"(hi)); return r; }
__device__ __forceinline__ float bf_lo(unsigned w) { return __uint_as_float(w << 16); }
__device__ __forceinline__ float bf_hi(unsigned w) { return __uint_as_float(w & 0xffff0000u); }
template <int M> __device__ __forceinline__ float swz_xor(float v) { return __builtin_bit_cast(float, __builtin_amdgcn_ds_swizzle(__builtin_bit_cast(int, v), (M << 10) | 0x1F)); }
__device__ __forceinline__ float wave_sum(float v) {
    v += swz_xor<1>(v); v += swz_xor<2>(v); v += swz_xor<4>(v); v += swz_xor<8>(v); v += swz_xor<16>(v);
    return v + __shfl_xor(v, 32);
}
__device__ __forceinline__ float sigmoidf_(float x) { return __builtin_amdgcn_rcpf(1.0f + __builtin_amdgcn_exp2f(-x * LOG2E)); }
__device__ __forceinline__ int clampi(int v, int lo, int hi) { return v < lo ? lo : (v > hi ? hi : v); }
__host__ __device__ __forceinline__ int ropeperm(int d) { return d < 16 ? 8 * (d >> 2) + (d & 3) : (d < 32 ? 8 * ((d - 16) >> 2) + 4 + (d & 3) : d); }

namespace pg8 {
constexpr int BM = 256, BK = 64, HALF = 128, HTB = HALF * BK * 2, STAGE_BYTES = 8 * HTB, NXCD = 8, WGM = 4;
__host__ __device__ __forceinline__ int lds_byte(int r, int c) { const int st = (r >> 4) * 2 + (c >> 5), rr = r & 15, cc = c & 31, ob = rr * 64 + cc * 2; return st * 1024 + (ob ^ (((ob >> 9) & 1) << 5)); }
__host__ __device__ __forceinline__ void stage_rc(int b, int& R, int& C) { const int st = b / 1024, sb = b % 1024, swz = sb ^ (((sb >> 9) & 1) << 5); R = (st >> 1) * 16 + swz / 64; C = (st & 1) * 32 + (swz % 64) / 2; }
__host__ __device__ __forceinline__ int perm32(int rho) { const int n = rho >> 4, i = rho & 15; return 8 * (i >> 2) + 4 * n + (i & 3); }

__device__ __forceinline__ void glds_s(unsigned voff, const void* base, unsigned ldsdst) {
    unsigned keep;
    asm volatile("s_mov_b32 %0, m0\n\ts_mov_b32 m0, %3\n\ts_nop 0\n\tglobal_load_lds_dwordx4 %1, %2\n\ts_mov_b32 m0, %0" : "=&s"(keep) : "v"(voff), "s"(base), "s"(ldsdst) : "memory");
}
struct Unit { int pm, pn, kind, pad; const char* A; const char* B; };

__device__ __forceinline__ void tile_of(int L, int nM, int nN, int& pm, int& pn) {
    const int nwg = nM * nN; int wgid = L;
    { const int q = nwg / NXCD, r = nwg % NXCD, xcd = wgid % NXCD, off = wgid / NXCD; wgid = (xcd < r ? xcd * (q + 1) : r * (q + 1) + (xcd - r) * q) + off; }
    const int nig = WGM * nN, gid = wgid / nig, fm = gid * WGM, gsz = (nM - fm) < WGM ? (nM - fm) : WGM;
    pm = fm + ((wgid % nig) % gsz); pn = (wgid % nig) / gsz;
}

template <class Epi, class Sched, bool ALIGN_EPI, bool SP2>
__device__ __forceinline__ void gemm_phase(LAS unsigned char* lds, const int K, const Sched& S, const Epi& E) {
    int tid = threadIdx.x; asm volatile("" : "+v"(tid));
    const int wid = __builtin_amdgcn_readfirstlane(tid >> 6), lane = tid & 63, wr = wid >> 2, wc = wid & 3, fr = lane & 15, fq = lane >> 4;
    const int nt = K / BK;
    unsigned voffA[2], voffB[2];
#pragma unroll
    for (int i = 0; i < 2; ++i) { int R, C; stage_rc(tid * 16 + i * 8192, R, C); const int Rb = Epi::PERM ? ((R & ~31) + perm32(R & 31)) : R;
        voffA[i] = (unsigned)(R * K + C) * 2u; voffB[i] = (unsigned)(Rb * K + C) * 2u; }
    const size_t kstep = (size_t)(BK * 2);
    const size_t hstep = (size_t)HALF * K * 2;
    const unsigned ldsw = (unsigned)wid * 1024u;
    const unsigned ldsbase = (unsigned)__builtin_amdgcn_readfirstlane((int)((unsigned)(uintptr_t)lds + ldsw));
    const int aoff = lds_byte(wr * 64 + fr, fq * 8), boff = lds_byte(wc * 32 + fr, fq * 8);
#define PG8_SA(b, h) (((b) * 2 + (h)) * HTB)
#define PG8_SB(b, h) ((4 + (b) * 2 + (h)) * HTB)
#define PG8_STAGE(bufoff, gbase, voff) do { _Pragma("unroll") for (int _i = 0; _i < 2; ++_i) \
        glds_s((voff)[_i], (const void*)(gbase), ldsbase + (unsigned)((bufoff) + _i * 8192)); } while (0)
#define PG8_LDA(dst, b, h) do { _Pragma("unroll") for (int m = 0; m < 4; ++m) _Pragma("unroll") for (int k = 0; k < 2; ++k) dst[m][k] = *(const LAS bf16x8*)(lds + PG8_SA(b, h) + aoff + m * 2048 + k * 1024); } while (0)
#define PG8_LDB(dst, b, h) do { _Pragma("unroll") for (int n = 0; n < 2; ++n) _Pragma("unroll") for (int k = 0; k < 2; ++k) dst[n][k] = *(const LAS bf16x8*)(lds + PG8_SB(b, h) + boff + n * 2048 + k * 1024); } while (0)
#define PG8_MMA(ai, bj, At, Bt) do { __builtin_amdgcn_s_setprio(1); _Pragma("unroll") for (int m = 0; m < 4; ++m) _Pragma("unroll") for (int n = 0; n < 2; ++n) _Pragma("unroll") for (int k = 0; k < 2; ++k) \
        acc[ai][bj][m][n] = __builtin_amdgcn_mfma_f32_16x16x32_bf16(Bt[n][k], At[m][k], acc[ai][bj][m][n], 0, 0, 0); __builtin_amdgcn_s_setprio(0); } while (0)
#define PG8_WAIT_V(n) asm volatile("s_waitcnt vmcnt(" #n ")" ::: "memory")
#define PG8_WAIT_L(n) asm volatile("s_waitcnt lgkmcnt(" #n ")" ::: "memory")
#define PG8_BAR __builtin_amdgcn_s_barrier()
#define PG8_SCHED __builtin_amdgcn_sched_barrier(0)
    Unit cur, nxt; int ui = 0;
    if (!S.next(0, cur)) return;
    f32x4 acc[2][2][4][2];
#pragma unroll
    for (int a = 0; a < 2; ++a)
#pragma unroll
        for (int b = 0; b < 2; ++b)
#pragma unroll
            for (int m = 0; m < 4; ++m)
#pragma unroll
                for (int n = 0; n < 2; ++n) acc[a][b][m][n] = (f32x4){0.f, 0.f, 0.f, 0.f};
    bf16x8 At[4][2], B0[2][2], B1[2][2];
    const char* cA = cur.A; const char* cB = cur.B;
    if constexpr (SP2) {
        PG8_STAGE(PG8_SB(0, 0), cB, voffB); PG8_STAGE(PG8_SB(0, 1), cB + hstep, voffB); PG8_STAGE(PG8_SA(0, 0), cA, voffA); PG8_STAGE(PG8_SA(0, 1), cA + hstep, voffA);
        if (wr == 1) PG8_BAR;
        PG8_WAIT_V(2); PG8_BAR;
        PG8_STAGE(PG8_SB(1, 0), cB + kstep, voffB); PG8_STAGE(PG8_SA(1, 0), cA + kstep, voffA); PG8_STAGE(PG8_SB(1, 1), cB + hstep + kstep, voffB);
        PG8_WAIT_V(6); PG8_BAR;
    } else {
        PG8_STAGE(PG8_SB(0, 0), cB, voffB); PG8_STAGE(PG8_SA(0, 0), cA, voffA); PG8_STAGE(PG8_SB(0, 1), cB + hstep, voffB); PG8_STAGE(PG8_SA(0, 1), cA + hstep, voffA);
        if (wr == 1) PG8_BAR;
        PG8_WAIT_V(4); PG8_BAR;
        PG8_STAGE(PG8_SB(1, 0), cB + kstep, voffB); PG8_STAGE(PG8_SA(1, 0), cA + kstep, voffA); PG8_STAGE(PG8_SB(1, 1), cB + hstep + kstep, voffB);
        PG8_WAIT_V(6); PG8_BAR;
    }
    for (;;) {
        const bool has_next = S.next(ui + 1, nxt);
        const char* nA = has_next ? nxt.A : cA; const char* nB = has_next ? nxt.B : cB;
        for (int t = 0; t < nt; t += 2) {
            const bool last = (t == nt - 2);
            const char* a1 = cA + (size_t)(t + 1) * kstep;
            const char* a2 = last ? nA : cA + (size_t)(t + 2) * kstep; const char* b2 = last ? nB : cB + (size_t)(t + 2) * kstep;
            const char* a3 = a2 + kstep; const char* b3 = b2 + kstep;
            if constexpr (SP2) {
            PG8_LDB(B0, 0, 0); PG8_LDB(B1, 0, 1); PG8_SCHED; PG8_LDA(At, 0, 0); PG8_STAGE(PG8_SA(1, 1), a1 + hstep, voffA);
            PG8_WAIT_V(8); PG8_WAIT_L(0); PG8_BAR; PG8_MMA(0, 0, At, B0); PG8_MMA(0, 1, At, B1); PG8_BAR; PG8_SCHED;
            PG8_LDA(At, 0, 1); PG8_STAGE(PG8_SB(0, 0), b2, voffB); PG8_STAGE(PG8_SB(0, 1), b2 + hstep, voffB); PG8_STAGE(PG8_SA(0, 0), a2, voffA);
            PG8_WAIT_V(8); PG8_WAIT_L(0); PG8_BAR; PG8_MMA(1, 0, At, B0); PG8_MMA(1, 1, At, B1); PG8_BAR; PG8_SCHED;
            PG8_LDB(B0, 1, 0); PG8_LDB(B1, 1, 1); PG8_SCHED; PG8_LDA(At, 1, 0); PG8_STAGE(PG8_SA(0, 1), a2 + hstep, voffA);
            PG8_WAIT_V(8); PG8_WAIT_L(0); PG8_BAR; PG8_MMA(0, 0, At, B0); PG8_MMA(0, 1, At, B1); PG8_BAR; PG8_SCHED;
            PG8_LDA(At, 1, 1); PG8_STAGE(PG8_SB(1, 0), b3, voffB); PG8_STAGE(PG8_SB(1, 1), b3 + hstep, voffB); PG8_STAGE(PG8_SA(1, 0), a3, voffA);
            PG8_WAIT_V(8); PG8_WAIT_L(0); PG8_BAR; PG8_MMA(1, 0, At, B0); PG8_MMA(1, 1, At, B1); PG8_BAR; PG8_SCHED;
            } else {
            PG8_LDB(B0, 0, 0); PG8_SCHED; PG8_LDA(At, 0, 0); PG8_STAGE(PG8_SA(1, 1), a1 + hstep, voffA);
            PG8_WAIT_L(8); PG8_BAR; PG8_WAIT_L(0); PG8_MMA(0, 0, At, B0); PG8_BAR; PG8_SCHED;
            PG8_LDB(B1, 0, 1); PG8_STAGE(PG8_SB(0, 0), b2, voffB);
            PG8_BAR; PG8_WAIT_L(0); PG8_MMA(0, 1, At, B1); PG8_BAR;
            PG8_LDA(At, 0, 1); PG8_STAGE(PG8_SA(0, 0), a2, voffA);
            PG8_BAR; PG8_WAIT_L(0); PG8_MMA(1, 0, At, B0); PG8_BAR; PG8_SCHED;
            PG8_STAGE(PG8_SB(0, 1), b2 + hstep, voffB);
            PG8_WAIT_V(6); PG8_BAR; PG8_MMA(1, 1, At, B1); PG8_BAR;
            PG8_LDB(B0, 1, 0); PG8_SCHED; PG8_LDA(At, 1, 0); PG8_STAGE(PG8_SA(0, 1), a2 + hstep, voffA);
            PG8_WAIT_L(8); PG8_BAR; PG8_WAIT_L(0); PG8_MMA(0, 0, At, B0); PG8_BAR; PG8_SCHED;
            PG8_LDB(B1, 1, 1); PG8_STAGE(PG8_SB(1, 0), b3, voffB);
            PG8_BAR; PG8_WAIT_L(0); PG8_MMA(0, 1, At, B1); PG8_BAR;
            PG8_LDA(At, 1, 1); PG8_STAGE(PG8_SA(1, 0), a3, voffA);
            PG8_BAR; PG8_WAIT_L(0); PG8_MMA(1, 0, At, B0); PG8_BAR; PG8_SCHED;
            PG8_STAGE(PG8_SB(1, 1), b3 + hstep, voffB);
            PG8_WAIT_V(6); PG8_BAR; PG8_MMA(1, 1, At, B1); PG8_BAR;
            }
        }
        if constexpr (ALIGN_EPI) { if (wr == 0) PG8_BAR; }
        E(acc, cur, wr, wc, fr, fq);
        PG8_WAIT_V(0);
        if (!has_next) break;
        if (!Epi::keep(cur)) {
#pragma unroll
        for (int a = 0; a < 2; ++a)
#pragma unroll
            for (int b = 0; b < 2; ++b)
#pragma unroll
                for (int m = 0; m < 4; ++m)
#pragma unroll
                    for (int n = 0; n < 2; ++n) acc[a][b][m][n] = (f32x4){0.f, 0.f, 0.f, 0.f};
        }
        cur = nxt; cA = nA; cB = nB; ++ui;
        if constexpr (ALIGN_EPI) { if (wr == 1) PG8_BAR; }
    }
    PG8_WAIT_V(0);
    if constexpr (!ALIGN_EPI) { if (wr == 0) PG8_BAR; }
    PG8_BAR;
#undef PG8_SA
#undef PG8_SB
#undef PG8_STAGE
#undef PG8_LDA
#undef PG8_LDB
#undef PG8_MMA
#undef PG8_WAIT_V
#undef PG8_WAIT_L
#undef PG8_BAR
#undef PG8_SCHED
}

struct SchedStd {
    const char* A; const char* Bt; int nM, nN, K, G, c;
    __device__ __forceinline__ bool next(int i, Unit& u) const {
        const int L = i * G + c; if (L >= nM * nN) return false;
        tile_of(L, nM, nN, u.pm, u.pn); u.kind = 0; u.pad = 0;
        u.A = A + (size_t)u.pm * 256 * K * 2; u.B = Bt + (size_t)u.pn * 256 * K * 2; return true;
    }
};
struct SchedIn {
    const char* H; const char* WinT; int G, c;
    __device__ __forceinline__ bool next(int i, Unit& u) const {
        constexpr int NMAINU = 64 * 29, NVU = 5 * 64; const size_t tb = (size_t)256 * DM * 2;
        const int L = i * G + c; u.pad = 0;
        if (L < NMAINU) { tile_of(L, 64, 29, u.pm, u.pn); u.kind = 0; u.A = H + u.pm * tb; u.B = WinT + u.pn * tb; return true; }
        const int L2 = L - NMAINU; if (L2 >= NVU) return false;
        u.kind = 1; u.pm = L2 % 5; u.pn = L2 / 5; u.A = WinT + (size_t)(29 + u.pm) * tb; u.B = H + u.pn * tb; return true;
    }
};
struct SchedProj {
    const char* OA; const char* OB; const char* WA; const char* WB; int G, c;
    __device__ __forceinline__ bool next(int i, Unit& u) const {
        const int L = (i >> 1) * G + c; if (L >= 64 * 8) return false;
        tile_of(L, 64, 8, u.pm, u.pn); u.kind = i & 1; u.pad = 0; const size_t tb = (size_t)256 * 1024 * 2;
        u.A = ((i & 1) ? OB : OA) + u.pm * tb; u.B = ((i & 1) ? WB : WA) + u.pn * tb; return true;
    }
};

__device__ __forceinline__ u32x4 pack8(const f32x4 v0, const f32x4 v1) { u32x4 w; w.x = cvt_pk_bf16(v0[0], v0[1]); w.y = cvt_pk_bf16(v0[2], v0[3]); w.z = cvt_pk_bf16(v1[0], v1[1]); w.w = cvt_pk_bf16(v1[2], v1[3]); return w; }

struct EpiStore {
    static constexpr bool PERM = true; static __device__ __forceinline__ bool keep(const Unit&) { return false; }
    bf16_t* O; int ldc;
    __device__ __forceinline__ void operator()(const f32x4 (&acc)[2][2][4][2], const Unit& u, int wr, int wc, int fr, int fq) const {
        const int row0 = u.pm * BM + wr * 64 + fr, col0 = u.pn * BM + wc * 32 + 8 * fq;
#pragma unroll
        for (int ai = 0; ai < 2; ++ai)
#pragma unroll
            for (int m = 0; m < 4; ++m) { bf16_t* rowp = O + (size_t)(row0 + ai * HALF + m * 16) * ldc + col0;
#pragma unroll
                for (int bj = 0; bj < 2; ++bj) *(u32x4*)(rowp + bj * HALF) = pack8(acc[ai][bj][m][0], acc[ai][bj][m][1]); }
    }
};

struct EpiIn {
    static constexpr bool PERM = true; static __device__ __forceinline__ bool keep(const Unit&) { return false; }
    bf16_t* QKG; bf16_t* Vt; const float* nw; const float* ropec; const float* ropes; LAS float* xl;
    __device__ __forceinline__ void operator()(const f32x4 (&acc)[2][2][4][2], const Unit& u, int wr, int wc, int fr, int fq) const {
        const int row0 = u.pm * BM + wr * 64 + fr, col0 = u.pn * BM + wc * 32 + 8 * fq;
        if (u.kind == 1) {
#pragma unroll
            for (int ai = 0; ai < 2; ++ai)
#pragma unroll
                for (int m = 0; m < 4; ++m) { bf16_t* rowp = Vt + (size_t)(row0 + ai * HALF + m * 16) * VT_LD + col0;
#pragma unroll
                    for (int bj = 0; bj < 2; ++bj) *(u32x4*)(rowp + bj * HALF) = pack8(acc[ai][bj][m][0], acc[ai][bj][m][1]); }
            return;
        }
        const int pn = u.pn;
        if (pn >= 13) {
#pragma unroll
            for (int ai = 0; ai < 2; ++ai)
#pragma unroll
                for (int m = 0; m < 4; ++m) { bf16_t* rowp = QKG + (size_t)(row0 + ai * HALF + m * 16) * QKG_LD + col0;
#pragma unroll
                    for (int bj = 0; bj < 2; ++bj) { f32x4 v0 = acc[ai][bj][m][0], v1 = acc[ai][bj][m][1];
#pragma unroll
                        for (int e = 0; e < 4; ++e) { v0[e] = sigmoidf_(v0[e]); v1[e] = sigmoidf_(v1[e]); }
                        *(u32x4*)(rowp + bj * HALF) = pack8(v0, v1); } }
            return;
        }
        const bool isA = pn <= 4, isQ = (pn <= 3) || (pn >= 5 && pn <= 8);
        const float* gw = nw + (pn <= 3 ? 0 : (pn == 4 ? 128 : (pn <= 8 ? 256 : 384)));
#pragma unroll
        for (int ai = 0; ai < 2; ++ai)
#pragma unroll
            for (int m = 0; m < 4; ++m)
#pragma unroll
                for (int bj = 0; bj < 2; ++bj) { const f32x4 a = acc[ai][bj][m][0], b = acc[ai][bj][m][1];
                    float s = (a[0] * a[0] + a[1] * a[1]) + (a[2] * a[2] + a[3] * a[3]) + (b[0] * b[0] + b[1] * b[1]) + (b[2] * b[2] + b[3] * b[3]);
                    s += swz_xor<16>(s); s += __shfl_xor(s, 32);
                    if (fq == 0) xl[((ai * HALF + wr * 64 + m * 16 + fr) * 2 + bj) * 4 + wc] = s; }
        asm volatile("s_waitcnt lgkmcnt(0)" ::: "memory"); __builtin_amdgcn_s_barrier(); asm volatile("" ::: "memory");
        f32x4 g0, g1;
        if (isA && wc == 0) { g0 = *(const f32x4*)(gw + 4 * fq); g1 = *(const f32x4*)(gw + 16 + 4 * fq); }
        else { g0 = *(const f32x4*)(gw + wc * 32 + 8 * fq); g1 = *(const f32x4*)(gw + wc * 32 + 8 * fq + 4); }
        const float qs = isQ ? C2 : 1.0f;
#pragma unroll
        for (int ai = 0; ai < 2; ++ai)
#pragma unroll
            for (int m = 0; m < 4; ++m) { const int rl = ai * HALF + wr * 64 + m * 16 + fr; const int row = u.pm * BM + rl;
                bf16_t* rowp = QKG + (size_t)row * QKG_LD + col0;
                f32x4 cs = (f32x4){1.f, 1.f, 1.f, 1.f}, sn = (f32x4){0.f, 0.f, 0.f, 0.f};
                if (isA && wc == 0) { const int pos = row & (SEQ - 1); cs = *(const f32x4*)(ropec + pos * 16 + 4 * fq); sn = *(const f32x4*)(ropes + pos * 16 + 4 * fq); }
#pragma unroll
                for (int bj = 0; bj < 2; ++bj) {
                    const f32x4 ps = *(const LAS f32x4*)(xl + (rl * 2 + bj) * 4);
                    const float rstd = 1.0f / sqrtf(((ps[0] + ps[1]) + (ps[2] + ps[3])) * (1.0f / 128.0f) + EPS);
                    f32x4 v0 = acc[ai][bj][m][0] * rstd * g0, v1 = acc[ai][bj][m][1] * rstd * g1;
                    if (isA && wc == 0) { const f32x4 x1 = v0, x2 = v1; v0 = x1 * cs - x2 * sn; v1 = x2 * cs + x1 * sn; }
                    v0 = v0 * qs; v1 = v1 * qs;
                    *(u32x4*)(rowp + bj * HALF) = pack8(v0, v1); }
                asm volatile("" ::: "memory"); }
    }
};

struct EpiProj {
    static constexpr bool PERM = true; static __device__ __forceinline__ bool keep(const Unit& u) { return u.kind == 0; }
    bf16_t* MRG; const bf16_t* QKG;
    __device__ __forceinline__ void operator()(f32x4 (&acc)[2][2][4][2], const Unit& u, int wr, int wc, int fr, int fq) const {
        const int row0 = u.pm * BM + wr * 64 + fr, col0 = u.pn * BM + wc * 32 + 8 * fq;
#pragma unroll
        for (int ai = 0; ai < 2; ++ai)
#pragma unroll
            for (int m = 0; m < 4; ++m) { const size_t row = (size_t)(row0 + ai * HALF + m * 16);
#pragma unroll
                for (int bj = 0; bj < 2; ++bj) {
                    const u32x4 gb = *(const u32x4*)(QKG + row * QKG_LD + C_SB + col0 + bj * HALF);
                    f32x4 s0 = (f32x4){bf_lo(gb.x), bf_hi(gb.x), bf_lo(gb.y), bf_hi(gb.y)}, s1 = (f32x4){bf_lo(gb.z), bf_hi(gb.z), bf_lo(gb.w), bf_hi(gb.w)};
                    if (u.kind == 0) {
                        const u32x4 ga = *(const u32x4*)(QKG + row * QKG_LD + C_SA + col0 + bj * HALF);
#pragma unroll
                        for (int e = 0; e < 4; ++e) { s0[e] = __builtin_amdgcn_rcpf(s0[e]); s1[e] = __builtin_amdgcn_rcpf(s1[e]); }
                        s0 = s0 * (f32x4){bf_lo(ga.x), bf_hi(ga.x), bf_lo(ga.y), bf_hi(ga.y)}; s1 = s1 * (f32x4){bf_lo(ga.z), bf_hi(ga.z), bf_lo(ga.w), bf_hi(ga.w)};
                        acc[ai][bj][m][0] = acc[ai][bj][m][0] * s0; acc[ai][bj][m][1] = acc[ai][bj][m][1] * s1;
                    } else *(u32x4*)(MRG + row * DM + col0 + bj * HALF) = pack8(acc[ai][bj][m][0] * s0, acc[ai][bj][m][1] * s1); }
                if (m & 1) asm volatile("" ::: "memory"); }
    }
};

struct EpiRes {
    static constexpr bool PERM = false; static __device__ __forceinline__ bool keep(const Unit&) { return false; }
    const float* xin; float* xout; const float* gate; bool stream;
    __device__ __forceinline__ void operator()(const f32x4 (&acc)[2][2][4][2], const Unit& u, int wr, int wc, int fr, int fq) const {
        const int row0 = u.pm * BM + wr * 64 + fr, col0 = u.pn * BM + wc * 32 + 4 * fq; const int b = (u.pm * BM) >> 12;
        f32x4 gv[2][2];
#pragma unroll
        for (int bj = 0; bj < 2; ++bj)
#pragma unroll
            for (int n = 0; n < 2; ++n) gv[bj][n] = *(const f32x4*)(gate + b * MODW + col0 + bj * HALF + n * 16);
#pragma unroll
        for (int ai = 0; ai < 2; ++ai)
#pragma unroll
            for (int m = 0; m < 4; ++m) { const size_t off = (size_t)(row0 + ai * HALF + m * 16) * DM + col0;
#pragma unroll
                for (int bj = 0; bj < 2; ++bj)
#pragma unroll
                    for (int n = 0; n < 2; ++n) { const f32x4 bs = stream ? __builtin_nontemporal_load((const f32x4*)(xin + off + bj * HALF + n * 16)) : *(const f32x4*)(xin + off + bj * HALF + n * 16);
                        *(f32x4*)(xout + off + bj * HALF + n * 16) = bs + gv[bj][n] * acc[ai][bj][m][n]; }
                if (m & 1) asm volatile("" ::: "memory"); }
    }
};

__device__ __forceinline__ float dpp_ror1(float x) { return __builtin_bit_cast(float, __builtin_amdgcn_update_dpp(0, __builtin_bit_cast(int, x), 0x121, 0xF, 0xF, false)); }
__device__ __forceinline__ float dpp_rol1(float x) { return __builtin_bit_cast(float, __builtin_amdgcn_update_dpp(0, __builtin_bit_cast(int, x), 0x12F, 0xF, 0xF, false)); }
__device__ __forceinline__ f32x4 ror1v(const f32x4 v) { return (f32x4){dpp_ror1(v[0]), dpp_ror1(v[1]), dpp_ror1(v[2]), dpp_ror1(v[3])}; }
__device__ __forceinline__ f32x4 rol1v(const f32x4 v) { return (f32x4){dpp_rol1(v[0]), dpp_rol1(v[1]), dpp_rol1(v[2]), dpp_rol1(v[3])}; }

struct EpiUp {
    static constexpr bool PERM = true; static __device__ __forceinline__ bool keep(const Unit&) { return false; }
    bf16_t* ACT; float* HALO; const float* cw; const float* cb; LAS float* xl;
    __device__ __forceinline__ void operator()(const f32x4 (&acc)[2][2][4][2], const Unit& u, int wr, int wc, int fr, int fq) const {
        const int colw = 32 * wc + 8 * fq;
#pragma unroll
        for (int ai = 0; ai < 2; ++ai) { const int blk = 2 * ai + wr;
            if (fr == 0) {
#pragma unroll
                for (int bj = 0; bj < 2; ++bj)
#pragma unroll
                    for (int n = 0; n < 2; ++n) *(LAS f32x4*)(xl + (blk * 2 + 0) * 256 + 128 * bj + colw + 4 * n) = acc[ai][bj][0][n]; }
            if (fr == 15) {
#pragma unroll
                for (int bj = 0; bj < 2; ++bj)
#pragma unroll
                    for (int n = 0; n < 2; ++n) *(LAS f32x4*)(xl + (blk * 2 + 1) * 256 + 128 * bj + colw + 4 * n) = acc[ai][bj][3][n]; } }
        if (wr == 0 && fr < 2) { float* hp = HALO + ((size_t)(u.pm * 4 + fr)) * FF2 + 256 * u.pn + colw;
#pragma unroll
            for (int bj = 0; bj < 2; ++bj)
#pragma unroll
                for (int n = 0; n < 2; ++n) *(f32x4*)(hp + 128 * bj + 4 * n) = acc[0][bj][0][n]; }
        if (wr == 1 && fr >= 14) { float* hp = HALO + ((size_t)(u.pm * 4 + 2 + (fr - 14))) * FF2 + 256 * u.pn + colw;
#pragma unroll
            for (int bj = 0; bj < 2; ++bj)
#pragma unroll
                for (int n = 0; n < 2; ++n) *(f32x4*)(hp + 128 * bj + 4 * n) = acc[1][bj][3][n]; }
        asm volatile("s_waitcnt lgkmcnt(0)" ::: "memory"); __builtin_amdgcn_s_barrier(); asm volatile("" ::: "memory");
        const f32x4 z4 = (f32x4){0.f, 0.f, 0.f, 0.f};
#pragma unroll
        for (int n = 0; n < 2; ++n) {
            const int ch = 128 * u.pn + colw + 4 * n;
            const f32x4 w0g = *(const f32x4*)(cw + ch), w1g = *(const f32x4*)(cw + FF2 + ch), w2g = *(const f32x4*)(cw + 2 * FF2 + ch), bg = *(const f32x4*)(cb + ch);
            const f32x4 w0v = *(const f32x4*)(cw + FF + ch), w1v = *(const f32x4*)(cw + FF2 + FF + ch), w2v = *(const f32x4*)(cw + 2 * FF2 + FF + ch), bv = *(const f32x4*)(cb + FF + ch);
#pragma unroll
            for (int ai = 0; ai < 2; ++ai) { const int blk = 2 * ai + wr;
                const f32x4 hpg = blk > 0 ? *(const LAS f32x4*)(xl + ((blk - 1) * 2 + 1) * 256 + colw + 4 * n) : z4;
                const f32x4 hpv = blk > 0 ? *(const LAS f32x4*)(xl + ((blk - 1) * 2 + 1) * 256 + 128 + colw + 4 * n) : z4;
                const f32x4 hng = blk < 3 ? *(const LAS f32x4*)(xl + ((blk + 1) * 2 + 0) * 256 + colw + 4 * n) : z4;
                const f32x4 hnv = blk < 3 ? *(const LAS f32x4*)(xl + ((blk + 1) * 2 + 0) * 256 + 128 + colw + 4 * n) : z4;
#pragma unroll
                for (int m = 0; m < 4; ++m) {
                    const f32x4 cg_ = acc[ai][0][m][n], cv_ = acc[ai][1][m][n];
                    const f32x4 ug0 = m > 0 ? ror1v(acc[ai][0][m - 1][n]) : hpg, uv0 = m > 0 ? ror1v(acc[ai][1][m - 1][n]) : hpv;
                    const f32x4 dg0 = m < 3 ? rol1v(acc[ai][0][m + 1][n]) : hng, dv0 = m < 3 ? rol1v(acc[ai][1][m + 1][n]) : hnv;
                    const f32x4 ug1 = ror1v(cg_), uv1 = ror1v(cv_), dg1 = rol1v(cg_), dv1 = rol1v(cv_);
                    f32x4 ug, uv, dg, dv;
#pragma unroll
                    for (int e = 0; e < 4; ++e) { ug[e] = fr == 0 ? ug0[e] : ug1[e]; uv[e] = fr == 0 ? uv0[e] : uv1[e]; dg[e] = fr == 15 ? dg0[e] : dg1[e]; dv[e] = fr == 15 ? dv0[e] : dv1[e]; }
                    const f32x4 gc = w0g * ug + w1g * cg_ + w2g * dg + bg, vc = w0v * uv + w1v * cv_ + w2v * dv + bv;
                    f32x4 r;
#pragma unroll
                    for (int e = 0; e < 4; ++e) r[e] = gc[e] * sigmoidf_(gc[e]) * vc[e];
                    u32x2 w; w.x = cvt_pk_bf16(r[0], r[1]); w.y = cvt_pk_bf16(r[2], r[3]);
                    *(u32x2*)(ACT + (size_t)(u.pm * BM + ai * HALF + wr * 64 + m * 16 + fr) * FF + ch) = w;
                    asm volatile("" ::: "memory");
                }
            }
        }
    }
};
}

namespace att {
constexpr int KROW = 272, VROW = 272, KBUF = 128 * KROW, VBUF = 128 * VROW, OFF_V = 2 * KBUF, OFF_TAB = OFF_V + 2 * VBUF + 64;
__device__ __forceinline__ int pi32(int r) { return (r & 19) | ((r & 4) << 1) | ((r & 8) >> 1); }
constexpr float THR = 8.0f;
constexpr int TAB_SENT = 640;
#define ATT_STAGE_DECL() \
    const int st_row = tid >> 4, st_ch = tid & 15; \
    const bf16_t* kg = QKG + (size_t)(b * SEQ + kt0 + st_row) * QKG_LD + kcol0 + st_ch * 8; \
    const bf16_t* vg = Vt + (size_t)(vrow0 + st_row) * VT_LD + b * SEQ + kt0 + st_ch * 8; \
    u32x4 kr0 = *(const u32x4*)kg, kr1 = *(const u32x4*)(kg + (size_t)32 * QKG_LD), kr2 = *(const u32x4*)(kg + (size_t)64 * QKG_LD), kr3 = *(const u32x4*)(kg + (size_t)96 * QKG_LD); \
    u32x4 vr0 = *(const u32x4*)vg, vr1 = *(const u32x4*)(vg + (size_t)32 * VT_LD), vr2 = *(const u32x4*)(vg + (size_t)64 * VT_LD), vr3 = *(const u32x4*)(vg + (size_t)96 * VT_LD);
#define ATT_STAGE_STEP() \
        unsigned char* Kb = lds + (s & 1) * KBUF; unsigned char* Vb = lds + OFF_V + (s & 1) * VBUF; \
        { unsigned char* kd = Kb + st_row * KROW + st_ch * 16; unsigned char* vd = Vb + st_row * VROW + st_ch * 16; \
          *(u32x4*)kd = kr0; *(u32x4*)(kd + 32 * KROW) = kr1; *(u32x4*)(kd + 64 * KROW) = kr2; *(u32x4*)(kd + 96 * KROW) = kr3; \
          *(u32x4*)vd = vr0; *(u32x4*)(vd + 32 * VROW) = vr1; *(u32x4*)(vd + 64 * VROW) = vr2; *(u32x4*)(vd + 96 * VROW) = vr3; } \
        __syncthreads(); \
        if (s + 1 < nst) { const bf16_t* kg2 = kg + (size_t)(s + 1) * 128 * QKG_LD; const bf16_t* vg2 = vg + (s + 1) * 128; \
            kr0 = *(const u32x4*)kg2; kr1 = *(const u32x4*)(kg2 + (size_t)32 * QKG_LD); kr2 = *(const u32x4*)(kg2 + (size_t)64 * QKG_LD); kr3 = *(const u32x4*)(kg2 + (size_t)96 * QKG_LD); \
            vr0 = *(const u32x4*)vg2; vr1 = *(const u32x4*)(vg2 + (size_t)32 * VT_LD); vr2 = *(const u32x4*)(vg2 + (size_t)64 * VT_LD); vr3 = *(const u32x4*)(vg2 + (size_t)96 * VT_LD); }

__device__ __forceinline__ void attn_win(unsigned char* lds, const int unit, const bf16_t* __restrict__ QKG, const bf16_t* __restrict__ Vt, bf16_t* __restrict__ Oout, const float* __restrict__ sink) {
    int tid = threadIdx.x; asm volatile("" : "+v"(tid));
    const int lane = tid & 63, wid = __builtin_amdgcn_readfirstlane(tid >> 6), q31 = lane & 31, hi = lane >> 5;
    const int qc = unit & 63, g = (unit >> 6) & 1, b = unit >> 7;
    const int head = 4 * g + (wid >> 1), qbase = 64 * qc + 32 * (wid & 1), qtok = qbase + q31, kcol0 = C_KA + 128 * g, vrow0 = 128 * g;
    int lo = 64 * qc - 128, hiE = 64 * qc + 192; lo = lo < 0 ? 0 : lo; hiE = hiE > SEQ ? SEQ : hiE; const int kt0 = lo, nt = (hiE - lo) >> 6, nst = (nt + 1) >> 1;
    bf16x8 qf[8];
    { const bf16_t* qp = QKG + (size_t)(b * SEQ + qtok) * QKG_LD + C_QA + 128 * head + 8 * hi;
#pragma unroll
      for (int d0 = 0; d0 < 8; ++d0) qf[d0] = *(const bf16x8*)(qp + 16 * d0); }
    float m_run = sink[head] * LOG2E, l_run = hi == 0 ? 1.0f : 0.0f;
    f32x16 o[4];
#pragma unroll
    for (int i = 0; i < 4; ++i) o[i] = f32x16{};
    ATT_STAGE_DECL()
    const int ka_off = pi32(q31) * KROW + hi * 16, va_off = q31 * VROW + hi * 16;
    for (int s = 0; s < nst; ++s) {
        ATT_STAGE_STEP()
#pragma unroll
        for (int h = 0; h < 2; ++h) { const int it = 2 * s + h; if (it < nt) {
        const unsigned char* Kh = Kb + h * 64 * KROW; const unsigned char* Vh = Vb + h * 128;
        const int kpos0 = kt0 + 64 * it;
        f32x16 p0 = f32x16{}, p1 = f32x16{};
#pragma unroll
        for (int d0 = 0; d0 < 8; ++d0) {
            const bf16x8 k0 = *(const bf16x8*)(Kh + ka_off + d0 * 32), k1 = *(const bf16x8*)(Kh + ka_off + 32 * KROW + d0 * 32);
            p0 = __builtin_amdgcn_mfma_f32_32x32x16_bf16(k0, qf[d0], p0, 0, 0, 0);
            p1 = __builtin_amdgcn_mfma_f32_32x32x16_bf16(k1, qf[d0], p1, 0, 0, 0);
        }
        if ((kpos0 - (qbase + 31) < -128) || (kpos0 + 63 - qbase > 128)) {
#pragma unroll
            for (int r = 0; r < 16; ++r) { const int d0 = kpos0 + 16 * (r >> 3) + 8 * hi + (r & 7) - qtok, d1 = d0 + 32;
                if (d0 > 128 || d0 < -128) p0[r] = -INFINITY; if (d1 > 128 || d1 < -128) p1[r] = -INFINITY; }
        }
        float mx = fmaxf(p0[0], p1[0]);
#pragma unroll
        for (int r = 1; r < 16; ++r) mx = fmaxf(mx, fmaxf(p0[r], p1[r]));
        mx = fmaxf(mx, __shfl_xor(mx, 32));
        if (__any(mx > m_run + THR)) { const float mnew = fmaxf(m_run, mx), alpha = __builtin_amdgcn_exp2f(m_run - mnew); m_run = mnew; l_run *= alpha;
#pragma unroll
            for (int i = 0; i < 4; ++i)
#pragma unroll
                for (int r = 0; r < 16; ++r) o[i][r] *= alpha; }
        float ls = 0.f;
#pragma unroll
        for (int r = 0; r < 16; ++r) { p0[r] = __builtin_amdgcn_exp2f(p0[r] - m_run); p1[r] = __builtin_amdgcn_exp2f(p1[r] - m_run); ls += p0[r] + p1[r]; }
        l_run += ls;
        u32x4 pw[4];
        pw[0] = (u32x4){cvt_pk_bf16(p0[0], p0[1]), cvt_pk_bf16(p0[2], p0[3]), cvt_pk_bf16(p0[4], p0[5]), cvt_pk_bf16(p0[6], p0[7])};
        pw[1] = (u32x4){cvt_pk_bf16(p0[8], p0[9]), cvt_pk_bf16(p0[10], p0[11]), cvt_pk_bf16(p0[12], p0[13]), cvt_pk_bf16(p0[14], p0[15])};
        pw[2] = (u32x4){cvt_pk_bf16(p1[0], p1[1]), cvt_pk_bf16(p1[2], p1[3]), cvt_pk_bf16(p1[4], p1[5]), cvt_pk_bf16(p1[6], p1[7])};
        pw[3] = (u32x4){cvt_pk_bf16(p1[8], p1[9]), cvt_pk_bf16(p1[10], p1[11]), cvt_pk_bf16(p1[12], p1[13]), cvt_pk_bf16(p1[14], p1[15])};
#pragma unroll
        for (int t = 0; t < 4; ++t)
#pragma unroll
            for (int db = 0; db < 4; ++db) {
                const bf16x8 vf = *(const bf16x8*)(Vh + va_off + db * 32 * VROW + t * 32);
                o[db] = __builtin_amdgcn_mfma_f32_32x32x16_bf16(vf, __builtin_bit_cast(bf16x8, pw[t]), o[db], 0, 0, 0);
            }
        } }
    }
    const float lt = l_run + __shfl_xor(l_run, 32), inv = 1.0f / lt;
    bf16_t* op = Oout + (size_t)(b * SEQ + qtok) * 1024 + 128 * head + 4 * hi;
#pragma unroll
    for (int db = 0; db < 4; ++db)
#pragma unroll
        for (int rg = 0; rg < 4; ++rg) { u32x2 w; w.x = cvt_pk_bf16(o[db][4 * rg] * inv, o[db][4 * rg + 1] * inv); w.y = cvt_pk_bf16(o[db][4 * rg + 2] * inv, o[db][4 * rg + 3] * inv);
            *(u32x2*)(op + 32 * db + 8 * rg) = w; }
    __syncthreads();
}

__device__ __forceinline__ void attn_na(unsigned char* lds, const int unit, const bf16_t* __restrict__ QKG, const bf16_t* __restrict__ Vt, bf16_t* __restrict__ Oout, const float* __restrict__ btab) {
    int tid = threadIdx.x; asm volatile("" : "+v"(tid));
    const int lane = tid & 63, wid = __builtin_amdgcn_readfirstlane(tid >> 6), q31 = lane & 31, hi = lane >> 5;
    const int R = unit & 15, hd = (unit >> 4) & 7, b = unit >> 7;
    const int rp = wid >> 2, j = wid & 3, ra = 4 * R + 2 * rp, rq = ra + (q31 >> 4), ccol = 16 * j + (q31 & 15), qtok = 64 * rq + ccol;
    const int c0 = j == 0 ? 0 : (j == 1 ? 8 : (j == 2 ? 24 : 32));
    const int kcol0 = C_KB + 128 * hd, vrow0 = 256 + 128 * hd;
    const int r_lo = clampi(4 * R - 4, 0, 56), r_hi = clampi(4 * R - 1, 0, 56) + 8, kt0 = 64 * r_lo, nt = r_hi - r_lo, nst = (nt + 1) >> 1;
    const int wa_lo = clampi(ra - 4, 0, 56), wa_hi = clampi(ra - 3, 0, 56) + 8;
    const int rsq = clampi(rq - 4, 0, 56), cs = clampi(ccol - 8, 0, 48);
    bf16x8 qf[8];
    { const bf16_t* qp = QKG + (size_t)(b * SEQ + qtok) * QKG_LD + C_QB + 128 * hd + 8 * hi;
#pragma unroll
      for (int d0 = 0; d0 < 8; ++d0) qf[d0] = *(const bf16x8*)(qp + 16 * d0); }
    float* tab = (float*)(lds + OFF_TAB);
    for (int i = tid; i < TAB_SENT + 48; i += 512) tab[i] = (i >= 16 && i < 16 + 15 * 31) ? btab[hd * (15 * 31) + (i - 16)] * LOG2E : (i >= TAB_SENT - 16 ? -INFINITY : 0.0f);
    const int lanepart = c0 + 8 * hi - ccol + 15;
    float addmask[16];
#pragma unroll
    for (int r = 0; r < 16; ++r) { const int kc = c0 + 16 * (r >> 3) + 8 * hi + (r & 7); addmask[r] = (kc >= cs && kc < cs + 16) ? 0.0f : -INFINITY; }
    float m_run = -1e30f, l_run = 0.0f;
    f32x16 o[4];
#pragma unroll
    for (int i = 0; i < 4; ++i) o[i] = f32x16{};
    ATT_STAGE_DECL()
    const int ka_off = (c0 + pi32(q31)) * KROW + hi * 16, va_off = q31 * VROW + c0 * 2 + hi * 16;
    for (int s = 0; s < nst; ++s) {
        ATT_STAGE_STEP()
#pragma unroll
        for (int h = 0; h < 2; ++h) { const int it = 2 * s + h; const int krow = r_lo + it;
        if (it < nt && krow >= wa_lo && krow < wa_hi) {
            const unsigned char* Kh = Kb + h * 64 * KROW; const unsigned char* Vh = Vb + h * 128;
            f32x16 p0 = f32x16{};
#pragma unroll
            for (int d0 = 0; d0 < 8; ++d0) {
                const bf16x8 k0 = *(const bf16x8*)(Kh + ka_off + d0 * 32);
                p0 = __builtin_amdgcn_mfma_f32_32x32x16_bf16(k0, qf[d0], p0, 0, 0, 0);
            }
            const bool rowok = krow >= rsq && krow < rsq + 8;
            const float* trp = tab + (rowok ? (krow - rq + 7) * 31 + 16 : TAB_SENT) + lanepart;
#pragma unroll
            for (int r = 0; r < 16; ++r) p0[r] = (p0[r] + trp[16 * (r >> 3) + (r & 7)]) + addmask[r];
            float mx = p0[0];
#pragma unroll
            for (int r = 1; r < 16; ++r) mx = fmaxf(mx, p0[r]);
            mx = fmaxf(mx, __shfl_xor(mx, 32));
            if (__any(mx > m_run + THR)) { const float mnew = fmaxf(m_run, mx), alpha = __builtin_amdgcn_exp2f(m_run - mnew); m_run = mnew; l_run *= alpha;
#pragma unroll
                for (int i = 0; i < 4; ++i)
#pragma unroll
                    for (int r = 0; r < 16; ++r) o[i][r] *= alpha; }
            float ls = 0.f;
#pragma unroll
            for (int r = 0; r < 16; ++r) { p0[r] = __builtin_amdgcn_exp2f(p0[r] - m_run); ls += p0[r]; }
            l_run += ls;
            u32x4 pw[2];
            pw[0] = (u32x4){cvt_pk_bf16(p0[0], p0[1]), cvt_pk_bf16(p0[2], p0[3]), cvt_pk_bf16(p0[4], p0[5]), cvt_pk_bf16(p0[6], p0[7])};
            pw[1] = (u32x4){cvt_pk_bf16(p0[8], p0[9]), cvt_pk_bf16(p0[10], p0[11]), cvt_pk_bf16(p0[12], p0[13]), cvt_pk_bf16(p0[14], p0[15])};
#pragma unroll
            for (int t = 0; t < 2; ++t)
#pragma unroll
                for (int db = 0; db < 4; ++db) {
                    const bf16x8 vf = *(const bf16x8*)(Vh + va_off + db * 32 * VROW + t * 32);
                    o[db] = __builtin_amdgcn_mfma_f32_32x32x16_bf16(vf, __builtin_bit_cast(bf16x8, pw[t]), o[db], 0, 0, 0);
                }
        } }
    }
    const float lt = l_run + __shfl_xor(l_run, 32), inv = 1.0f / lt;
    bf16_t* op = Oout + (size_t)(b * SEQ + qtok) * 1024 + 128 * hd + 4 * hi;
#pragma unroll
    for (int db = 0; db < 4; ++db)
#pragma unroll
        for (int rg = 0; rg < 4; ++rg) { u32x2 w; w.x = cvt_pk_bf16(o[db][4 * rg] * inv, o[db][4 * rg + 1] * inv); w.y = cvt_pk_bf16(o[db][4 * rg + 2] * inv, o[db][4 * rg + 3] * inv);
            *(u32x2*)(op + 32 * db + 8 * rg) = w; }
    __syncthreads();
}
#undef ATT_STAGE_DECL
#undef ATT_STAGE_STEP
}


typedef __attribute__((address_space(1))) unsigned gu32;
#define XB_TMO      128
#define XB_XCNT(j)  (256  + 64 * (j))
#define XB_XSUB(j)  (1280 + 64 * (j))
#define XB_XGEN(j)  (2304 + 64 * (j))
#define XB_TOP      3328
#define XB_TOPGEN   3392
#define XCD_BAR_WORDS 3456
#define XB_SPIN_CAP (1u << 18)

__device__ __forceinline__ unsigned xb_ld(unsigned* p)              { return __hip_atomic_load(p, __ATOMIC_RELAXED, __HIP_MEMORY_SCOPE_AGENT); }
__device__ __forceinline__ unsigned xb_add(unsigned* p, unsigned v) { return __hip_atomic_fetch_add(p, v, __ATOMIC_RELAXED, __HIP_MEMORY_SCOPE_AGENT); }
__device__ __forceinline__ unsigned xb_xcc_id() { return (unsigned)__builtin_amdgcn_s_getreg((3 << 11) | 20) & 0xFu; }
#define XB_SPIN(cond, bar) do { unsigned _sp = 0; while (cond) { __builtin_amdgcn_s_sleep(1); \
    if ((++_sp & 255u) == 0u) { if (xb_ld(&(bar)[XB_TMO])) break; if (_sp > XB_SPIN_CAP) { atomicAdd(&(bar)[XB_TMO], 1u); break; } } } } while (0)

struct XcdBarrier {
    unsigned* bar; unsigned x;
    volatile LAS unsigned* st;
};

__device__ __forceinline__ XcdBarrier xcd_barrier_post(unsigned* bar, volatile LAS unsigned* st) {
    XcdBarrier b; b.bar = bar; b.x = xb_xcc_id(); b.st = st;
    if (threadIdx.x == 0) (void)xb_add(&bar[XB_XCNT(b.x)], 1u);
    return b;
}
__device__ __forceinline__ void xcd_barrier_complete(unsigned* bar, unsigned x, unsigned& nloc, unsigned& nx) {
    const unsigned G = gridDim.x * gridDim.y * gridDim.z;
    unsigned sum, cnt, mine, sp = 0u;
    for (;;) {
        sum = 0u; cnt = 0u; mine = 0u;
#pragma unroll
        for (unsigned j = 0; j < 16; ++j) { const unsigned c = xb_ld(&bar[XB_XCNT(j)]); sum += c; cnt += (c > 0u) ? 1u : 0u; mine = (j == x) ? c : mine; }
        if (sum == G) break;
        __builtin_amdgcn_s_sleep(1);
        if ((++sp & 255u) == 0u) { if (xb_ld(&bar[XB_TMO])) break; if (sp > XB_SPIN_CAP) { atomicAdd(&bar[XB_TMO], 1u); break; } }
    }
    nloc = mine > 0u ? mine : 1u; nx = cnt > 0u ? cnt : 1u;
}

__device__ __forceinline__ void xcd_barrier(const XcdBarrier& b) {
    asm volatile("s_waitcnt vmcnt(0)" ::: "memory");
    __syncthreads();
    if (threadIdx.x == 0) {
        unsigned* bar = b.bar;
        __builtin_amdgcn_s_waitcnt(0);
        unsigned nloc = b.st[0], nx = b.st[1];
        if (nloc == 0u) { xcd_barrier_complete(bar, b.x, nloc, nx); b.st[0] = nloc; b.st[1] = nx; }
        const unsigned old = xb_add(&bar[XB_XSUB(b.x)], 1u);
        const unsigned gen = old / nloc;
        if (old + 1u == (gen + 1u) * nloc) {
            __builtin_amdgcn_fence(__ATOMIC_RELEASE, "agent");
            asm volatile("s_waitcnt vmcnt(0)" ::: "memory");
            const unsigned og = xb_add(&bar[XB_TOP], 1u);
            const unsigned tg = og / nx;
            if (og + 1u == (tg + 1u) * nx) xb_add(&bar[XB_TOPGEN], 1u);
            else XB_SPIN(xb_ld(&bar[XB_TOPGEN]) == tg, bar);
            __builtin_amdgcn_fence(__ATOMIC_ACQUIRE, "agent");
            xb_add(&bar[XB_XGEN(b.x)], 1u);
            asm volatile("s_waitcnt vmcnt(0)" ::: "memory");
        } else {
            XB_SPIN(xb_ld(&bar[XB_XGEN(b.x)]) == gen, bar);
            __builtin_amdgcn_fence(__ATOMIC_ACQUIRE, "agent");
            asm volatile("s_waitcnt vmcnt(0)" ::: "memory");
        }
    }
    __syncthreads();
}

template <int MAP>
__device__ __forceinline__ int row_map(int n) {
    if (MAP == 1) {
        if (n < 1024) return (n & ~127) + ropeperm(n & 127);
        if (n < 1280) return (n & ~127) + ropeperm(n & 127);
        if (n < 1536) return 7424 + (n - 1280);
        if (n < 2560) return 1280 + (n - 1536);
        if (n < 3584) return 2304 + (n - 2560);
        if (n < 4608) return 7680 + (n - 3584);
        if (n < 6656) return 3328 + (n - 4608);
        return 5376 + (n - 6656);
    }
    if (MAP == 2) { const int c = n < FF ? n : n - FF; return 256 * (c >> 7) + (c & 127) + (n < FF ? 0 : 128); }
    return n;
}
template <int MAP>
__device__ __forceinline__ void transpose_item(const float* __restrict__ W, int K, int N, bf16_t* __restrict__ WT, float* scr, int item, int lane) {
    const int nblk = N / 32, kb = item / nblk, nb = item % nblk, k0 = 64 * kb, n0 = 32 * nb;
#pragma unroll 8
    for (int i = 0; i < 32; ++i) { const int kk = 2 * i + (lane >> 5); scr[kk * 33 + (lane & 31)] = __builtin_nontemporal_load(W + (size_t)(k0 + kk) * N + n0 + (lane & 31)); }
    asm volatile("s_waitcnt lgkmcnt(0)" ::: "memory");
    const int c = lane & 7;
#pragma unroll
    for (int j = 0; j < 4; ++j) { const int n = (lane >> 3) + 8 * j; const float* s = scr + (8 * c) * 33 + n;
        u32x4 o; o.x = cvt_pk_bf16(s[0 * 33], s[1 * 33]); o.y = cvt_pk_bf16(s[2 * 33], s[3 * 33]); o.z = cvt_pk_bf16(s[4 * 33], s[5 * 33]); o.w = cvt_pk_bf16(s[6 * 33], s[7 * 33]);
        if (MAP == 1) *(u32x4*)(WT + (size_t)row_map<MAP>(n0 + n) * K + k0 + 8 * c) = o;
        else __builtin_nontemporal_store(o, (u32x4*)(WT + (size_t)row_map<MAP>(n0 + n) * K + k0 + 8 * c)); }
    asm volatile("s_waitcnt lgkmcnt(0)" ::: "memory");
}

struct Args {
    const float* in[20]; float* out; unsigned char* ws; double invf[16];
};

__device__ __forceinline__ void convert_weights(const Args& a, int l, unsigned char* lds, int gw, int NGW, int wave, int lane) {
    { int t_ = threadIdx.x; asm volatile("" : "+v"(t_)); lane = t_ & 63; }
    float* scr = (float*)(lds + wave * 16384);
    unsigned char* ws = a.ws;
    const float* w_in = a.in[6] + (size_t)l * DM * INC; const float* w_pa = a.in[13] + (size_t)l * 1024 * DM; const float* w_pb = a.in[14] + (size_t)l * 1024 * DM;
    const float* w_o = a.in[15] + (size_t)l * DM * DM; const float* w_up = a.in[16] + (size_t)l * DM * FF2; const float* w_dn = a.in[19] + (size_t)l * FF * DM;
    constexpr int I_IN = (DM / 64) * (INC / 32), I_PA = (1024 / 64) * (DM / 32), I_O = (DM / 64) * (DM / 32), I_UP = (DM / 64) * (FF2 / 32), I_DN = (FF / 64) * (DM / 32);
    constexpr int NITEMS = I_IN + 2 * I_PA + I_O + I_UP + I_DN;
    for (int it = gw; it < NITEMS; it += NGW) {
        int r = it;
        if (r < I_IN) { transpose_item<1>(w_in, DM, INC, (bf16_t*)(ws + WS_WIN), scr, r, lane); continue; } r -= I_IN;
        if (r < I_PA) { transpose_item<0>(w_pa, 1024, DM, (bf16_t*)(ws + WS_WPA), scr, r, lane); continue; } r -= I_PA;
        if (r < I_PA) { transpose_item<0>(w_pb, 1024, DM, (bf16_t*)(ws + WS_WPB), scr, r, lane); continue; } r -= I_PA;
        if (r < I_O) { transpose_item<0>(w_o, DM, DM, (bf16_t*)(ws + WS_WO), scr, r, lane); continue; } r -= I_O;
        if (r < I_UP) { transpose_item<2>(w_up, DM, FF2, (bf16_t*)(ws + WS_WUP), scr, r, lane); continue; } r -= I_UP;
        transpose_item<0>(w_dn, FF, DM, (bf16_t*)(ws + WS_WDN), scr, r, lane);
    }
}

__device__ __forceinline__ void mod_gemv(const Args& a, unsigned char* lds, int blk, int G, int tid) {
    float* sc = (float*)lds;
    float* red = (float*)(lds + 32768);
    const float* c = a.in[1]; const float* ada_w = a.in[2]; const float* ada_b = a.in[3]; float* mod = (float*)(a.ws + WS_MOD);
    bool staged = false;
    for (int unit = blk; unit < 192; unit += G) {
        if (!staged) { for (int i = tid; i < NB * DM; i += 512) { const float v = c[i]; sc[i] = v / (1.0f + __expf(-v)); } staged = true; }
        __syncthreads();
        const int l = unit / 96, n0 = (unit % 96) * 128, tn = tid & 31, kg = tid >> 5;
        const float* wp = ada_w + ((size_t)l * DM + kg) * (6 * DM) + n0 + 4 * tn;
        f32x4 acc[4];
#pragma unroll
        for (int b = 0; b < 4; ++b) acc[b] = (f32x4){0.f, 0.f, 0.f, 0.f};
#pragma unroll 8
        for (int k = 0; k < DM / 16; ++k) { const f32x4 w = __builtin_nontemporal_load((const f32x4*)(wp + (size_t)k * 16 * (6 * DM))); const int kk = kg + 16 * k;
#pragma unroll
            for (int b = 0; b < 4; ++b) acc[b] += w * sc[b * DM + kk]; }
#pragma unroll
        for (int b = 0; b < 4; ++b) *(f32x4*)(red + (kg * 4 + b) * 128 + 4 * tn) = acc[b];
        __syncthreads();
        { const int b = tid >> 7, n = tid & 127; float s = 0.f;
#pragma unroll
          for (int g = 0; g < 16; ++g) s += red[(g * 4 + b) * 128 + n];
          mod[((size_t)l * NB + b) * MODW + n0 + n] = s + ada_b[(size_t)l * MODW + n0 + n]; }
        __syncthreads();
    }
}

__device__ __forceinline__ void rope_table(const Args& a, int gt, int GT) {
    float* rc = (float*)(a.ws + WS_ROPEC); float* rs = (float*)(a.ws + WS_ROPES);
    for (int i = gt; i < SEQ * 16; i += GT) {
        const int pos = i >> 4, j = i & 15;
        const double ang = (double)pos * a.invf[j];
        const double TWO_PI_HI = 6.283185307179586232, TWO_PI_LO = 2.4492935982947064e-16;
        const double n = rint(ang * 0.15915494309189534561);
        double r = fma(-n, TWO_PI_HI, ang); r = fma(-n, TWO_PI_LO, r);
        const double r2 = r * r;
        double sp = 1.0, cp = 1.0;
#pragma unroll
        for (int t = 16; t >= 1; --t) { sp = 1.0 - r2 * (1.0 / (double)((2 * t) * (2 * t + 1))) * sp; cp = 1.0 - r2 * (1.0 / (double)((2 * t - 1) * (2 * t))) * cp; }
        rc[i] = (float)cp; rs[i] = (float)(r * sp);
    }
}

__device__ __forceinline__ void norm_rows(const float* x, bf16_t* H, const float* g, const float* modl, int sh_off, int sc_off, int gw, int NGW, int lane, bool stream) {
    { int t_ = threadIdx.x; asm volatile("" : "+v"(t_)); lane = t_ & 63; }
    const int per_b = SEQ / NGW;
    if (NGW == 2048) {
        const int blk_ = gw >> 3, wv_ = gw & 7, x_ = blk_ & 7, i_ = blk_ >> 3, b = x_ >> 1, rbase = 2048 * x_ + 64 * i_ + 8 * wv_;
        f32x4 gp[8], sp[8];
#pragma unroll
        for (int j = 0; j < 8; ++j) { const int col = 4 * lane + 256 * j;
            gp[j] = *(const f32x4*)(g + col) * (*(const f32x4*)(modl + b * MODW + sc_off + col) + 1.0f); sp[j] = *(const f32x4*)(modl + b * MODW + sh_off + col); }
        for (int k = 0; k < 8; k += 2) {
            const int m0 = rbase + k, m1 = m0 + 1;
            const f32x4* x0 = (const f32x4*)(x + (size_t)m0 * DM) + lane; const f32x4* x1 = (const f32x4*)(x + (size_t)m1 * DM) + lane;
            f32x4 v0[8], v1[8]; float s0 = 0.f, s1 = 0.f;
            if (stream) { _Pragma("unroll") for (int j = 0; j < 8; ++j) { v0[j] = __builtin_nontemporal_load(x0 + 64 * j); v1[j] = __builtin_nontemporal_load(x1 + 64 * j); } }
            else { _Pragma("unroll") for (int j = 0; j < 8; ++j) { v0[j] = x0[64 * j]; v1[j] = x1[64 * j]; } }
#pragma unroll
            for (int j = 0; j < 8; ++j) { s0 += (v0[j][0] * v0[j][0] + v0[j][1] * v0[j][1]) + (v0[j][2] * v0[j][2] + v0[j][3] * v0[j][3]);
                                          s1 += (v1[j][0] * v1[j][0] + v1[j][1] * v1[j][1]) + (v1[j][2] * v1[j][2] + v1[j][3] * v1[j][3]); }
            const float r0 = 1.0f / sqrtf(wave_sum(s0) * (1.0f / DM) + EPS), r1 = 1.0f / sqrtf(wave_sum(s1) * (1.0f / DM) + EPS);
            u32x2* o0 = (u32x2*)(H + (size_t)m0 * DM) + lane; u32x2* o1 = (u32x2*)(H + (size_t)m1 * DM) + lane;
#pragma unroll
            for (int j = 0; j < 8; ++j) { const f32x4 a = (v0[j] * r0) * gp[j] + sp[j], c = (v1[j] * r1) * gp[j] + sp[j];
                u32x2 w; w.x = cvt_pk_bf16(a[0], a[1]); w.y = cvt_pk_bf16(a[2], a[3]); o0[64 * j] = w;
                u32x2 z; z.x = cvt_pk_bf16(c[0], c[1]); z.y = cvt_pk_bf16(c[2], c[3]); o1[64 * j] = z; }
        }
        return;
    }
    if (per_b * NGW == SEQ && (per_b & 1) == 0) {
        for (int b = 0; b < NB; ++b) {
            f32x4 gp[8], sp[8];
#pragma unroll
            for (int j = 0; j < 8; ++j) { const int col = 4 * lane + 256 * j;
                gp[j] = *(const f32x4*)(g + col) * (*(const f32x4*)(modl + b * MODW + sc_off + col) + 1.0f); sp[j] = *(const f32x4*)(modl + b * MODW + sh_off + col); }
            for (int k = 0; k < per_b; k += 2) {
                const int m0 = b * SEQ + gw + NGW * k, m1 = m0 + NGW;
                const f32x4* x0 = (const f32x4*)(x + (size_t)m0 * DM) + lane; const f32x4* x1 = (const f32x4*)(x + (size_t)m1 * DM) + lane;
                f32x4 v0[8], v1[8]; float s0 = 0.f, s1 = 0.f;
                if (stream) { _Pragma("unroll") for (int j = 0; j < 8; ++j) { v0[j] = __builtin_nontemporal_load(x0 + 64 * j); v1[j] = __builtin_nontemporal_load(x1 + 64 * j); } }
                else { _Pragma("unroll") for (int j = 0; j < 8; ++j) { v0[j] = x0[64 * j]; v1[j] = x1[64 * j]; } }
#pragma unroll
                for (int j = 0; j < 8; ++j) { s0 += (v0[j][0] * v0[j][0] + v0[j][1] * v0[j][1]) + (v0[j][2] * v0[j][2] + v0[j][3] * v0[j][3]);
                                              s1 += (v1[j][0] * v1[j][0] + v1[j][1] * v1[j][1]) + (v1[j][2] * v1[j][2] + v1[j][3] * v1[j][3]); }
                const float r0 = 1.0f / sqrtf(wave_sum(s0) * (1.0f / DM) + EPS), r1 = 1.0f / sqrtf(wave_sum(s1) * (1.0f / DM) + EPS);
                u32x2* o0 = (u32x2*)(H + (size_t)m0 * DM) + lane; u32x2* o1 = (u32x2*)(H + (size_t)m1 * DM) + lane;
#pragma unroll
                for (int j = 0; j < 8; ++j) { const f32x4 a = (v0[j] * r0) * gp[j] + sp[j], c = (v1[j] * r1) * gp[j] + sp[j];
                    u32x2 w; w.x = cvt_pk_bf16(a[0], a[1]); w.y = cvt_pk_bf16(a[2], a[3]); o0[64 * j] = w;
                    u32x2 z; z.x = cvt_pk_bf16(c[0], c[1]); z.y = cvt_pk_bf16(c[2], c[3]); o1[64 * j] = z; }
            }
        }
        return;
    }
    for (int m = gw; m < MTOK; m += NGW) {
        const int b = m >> 12;
        const f32x4* xr = (const f32x4*)(x + (size_t)m * DM) + lane;
        f32x4 v[8]; float s = 0.f;
#pragma unroll
        for (int j = 0; j < 8; ++j) { v[j] = xr[64 * j]; s += (v[j][0] * v[j][0] + v[j][1] * v[j][1]) + (v[j][2] * v[j][2] + v[j][3] * v[j][3]); }
        const float rstd = 1.0f / sqrtf(wave_sum(s) * (1.0f / DM) + EPS);
        u32x2* o8 = (u32x2*)(H + (size_t)m * DM) + lane;
#pragma unroll
        for (int j = 0; j < 8; ++j) { const int col = 4 * lane + 256 * j;
            const f32x4 gv = *(const f32x4*)(g + col), scv = *(const f32x4*)(modl + b * MODW + sc_off + col), shv = *(const f32x4*)(modl + b * MODW + sh_off + col);
            const f32x4 r = (v[j] * rstd * gv) * (scv + 1.0f) + shv;
            u32x2 w; w.x = cvt_pk_bf16(r[0], r[1]); w.y = cvt_pk_bf16(r[2], r[3]); o8[64 * j] = w; }
    }
}

__device__ __forceinline__ void ffn_edge_fix(const float* __restrict__ HALO, bf16_t* __restrict__ ACT, const float* __restrict__ cw, const float* __restrict__ cb, int pm, int tid) {
    tid = threadIdx.x; asm volatile("" : "+v"(tid));
    for (int it = tid; it < 2 * (FF / 4); it += 512) {
        const int which = it >= (FF / 4), c = 4 * (it - which * (FF / 4)), t = c >> 7, w = c & 127, col = 256 * t + w;
        const float* hp; const float* hc; const float* hn; bool hasp = true, hasn = true;
        if (!which) { hasp = (pm & 15) != 0; hp = HALO + (size_t)((pm - 1) * 4 + 3) * FF2; hc = HALO + (size_t)(pm * 4 + 0) * FF2; hn = HALO + (size_t)(pm * 4 + 1) * FF2; }
        else { hasn = (pm & 15) != 15; hp = HALO + (size_t)(pm * 4 + 2) * FF2; hc = HALO + (size_t)(pm * 4 + 3) * FF2; hn = HALO + (size_t)((pm + 1) * 4 + 0) * FF2; }
        const f32x4 z4 = (f32x4){0.f, 0.f, 0.f, 0.f};
        const f32x4 pg = hasp ? *(const f32x4*)(hp + col) : z4, pv = hasp ? *(const f32x4*)(hp + col + 128) : z4;
        const f32x4 cg_ = *(const f32x4*)(hc + col), cv_ = *(const f32x4*)(hc + col + 128);
        const f32x4 ng = hasn ? *(const f32x4*)(hn + col) : z4, nv = hasn ? *(const f32x4*)(hn + col + 128) : z4;
        const f32x4 gc = *(const f32x4*)(cw + c) * pg + *(const f32x4*)(cw + FF2 + c) * cg_ + *(const f32x4*)(cw + 2 * FF2 + c) * ng + *(const f32x4*)(cb + c);
        const f32x4 vc = *(const f32x4*)(cw + FF + c) * pv + *(const f32x4*)(cw + FF2 + FF + c) * cv_ + *(const f32x4*)(cw + 2 * FF2 + FF + c) * nv + *(const f32x4*)(cb + FF + c);
        f32x4 r;
#pragma unroll
        for (int e = 0; e < 4; ++e) r[e] = gc[e] * sigmoidf_(gc[e]) * vc[e];
        u32x2 o; o.x = cvt_pk_bf16(r[0], r[1]); o.y = cvt_pk_bf16(r[2], r[3]);
        *(u32x2*)(ACT + (size_t)(pm * 256 + (which ? 255 : 0)) * FF + c) = o;
    }
}

__global__ void __launch_bounds__(512, 2) fwd_mega(Args a) {
    extern __shared__ __attribute__((aligned(16))) unsigned char lds[];
    cg::grid_group grid = cg::this_grid();
    const int tid = threadIdx.x, lane = tid & 63, wave = __builtin_amdgcn_readfirstlane(tid >> 6);
    const int G = gridDim.x, blk = blockIdx.x;
    const int gw = blk * 8 + wave, NGW = G * 8;
    unsigned char* ws = a.ws;
    LAS unsigned char* ldsL = (LAS unsigned char*)lds;
    float* mod = (float*)(ws + WS_MOD);
    bf16_t* H = (bf16_t*)(ws + WS_H); bf16_t* QKG = (bf16_t*)(ws + WS_QKG); bf16_t* Vt = (bf16_t*)(ws + WS_VT);
    bf16_t* OA = (bf16_t*)(ws + WS_OA); bf16_t* OB = (bf16_t*)(ws + WS_OB); bf16_t* T1 = (bf16_t*)(ws + WS_T1); bf16_t* MRG = (bf16_t*)(ws + WS_MRG);
    float* HALO = (float*)(ws + WS_HALO); bf16_t* ACT = (bf16_t*)(ws + WS_ACT);

    if (tid < 2) ((volatile LAS unsigned*)(ldsL + MISC_OFF))[tid] = 0u;
    __syncthreads();
    const XcdBarrier xbar = xcd_barrier_post((unsigned*)(ws + WS_BAR), (volatile LAS unsigned*)(ldsL + MISC_OFF));
#define GSYNC() xcd_barrier(xbar)
    if (a.ws == nullptr) grid.sync();
    mod_gemv(a, lds, blk, G, tid);
    rope_table(a, blk * 512 + tid, G * 512);
    if (blk == G - 1 && tid < 256) { float* nwp = (float*)(ws + WS_NW); const int l_ = tid >> 7, d_ = tid & 127;
        nwp[l_ * 512 + d_] = a.in[7][tid]; nwp[l_ * 512 + 128 + d_] = a.in[8][tid]; nwp[l_ * 512 + 256 + d_] = a.in[9][tid]; nwp[l_ * 512 + 384 + d_] = a.in[10][tid]; }
    convert_weights(a, 0, lds, gw, NGW, wave, lane);
    GSYNC();

    for (int l = 0; l < 2; ++l) {
        const float* xin = l == 0 ? a.in[0] : a.out;
        const float* modl = mod + (size_t)l * NB * MODW;
        if (l == 1) convert_weights(a, 1, lds, gw, NGW, wave, lane);
        norm_rows(xin, H, a.in[4] + l * DM, modl, 0, DM, gw, NGW, lane, l == 0);
        GSYNC();
        { pg8::SchedIn S{(const char*)H, (const char*)(ws + WS_WIN), G, blk};
          pg8::EpiIn E{QKG, Vt, (const float*)(ws + WS_NW) + l * 512, (const float*)(ws + WS_ROPEC), (const float*)(ws + WS_ROPES), (LAS float*)(ldsL + XL_OFF)};
          pg8::gemm_phase<pg8::EpiIn, pg8::SchedIn, true, true>(ldsL, DM, S, E); }
        GSYNC();
        { const int vcu = (blk & 7) * 32 + (blk >> 3), xi = vcu & 31, xc = vcu >> 5; const bool xm = (G == 256);
#pragma nounroll
          for (int k = 0; k < (xm ? 4 : (1024 + G - 1) / G); ++k) {
              int u = blk + k * G;
              if (xm) {
                  const int bb = xc >> 1, hf = xc & 1;
                  if (k < 2) { const int uu = 2 * xi + k; u = (bb * 2 + (uu >> 5)) * 64 + 32 * hf + (uu & 31); }
                  else { const int uu = 32 * (k - 2) + xi; u = 512 + (bb * 8 + (uu >> 3)) * 16 + 8 * hf + (uu & 7); } }
              if (u >= 1024) break;
              if (u < 512) att::attn_win(lds, u, QKG, Vt, OA, a.in[11] + l * 8);
              else att::attn_na(lds, u - 512, QKG, Vt, OB, a.in[12] + (size_t)l * 8 * 15 * 31);
          } }
        GSYNC();
        { pg8::SchedProj S{(const char*)OA, (const char*)OB, (const char*)(ws + WS_WPA), (const char*)(ws + WS_WPB), G, blk};
          pg8::EpiProj E{MRG, QKG};
          pg8::gemm_phase<pg8::EpiProj, pg8::SchedProj, true, true>(ldsL, 1024, S, E); }
        GSYNC();
        { pg8::SchedStd S{(const char*)MRG, (const char*)(ws + WS_WO), 64, 8, DM, G, blk};
          pg8::EpiRes E{xin, a.out, modl + 2 * DM, l == 0};
          pg8::gemm_phase<pg8::EpiRes, pg8::SchedStd, true, true>(ldsL, DM, S, E); }
        GSYNC();
        norm_rows(a.out, H, a.in[5] + l * DM, modl, 3 * DM, 4 * DM, gw, NGW, lane, false);
        GSYNC();
        { pg8::SchedStd S{(const char*)H, (const char*)(ws + WS_WUP), 64, 44, DM, G, blk};
          pg8::EpiUp E{ACT, HALO, a.in[17] + (size_t)l * 3 * FF2, a.in[18] + (size_t)l * FF2, (LAS float*)(ldsL + XL_OFF)};
          pg8::gemm_phase<pg8::EpiUp, pg8::SchedStd, true, true>(ldsL, DM, S, E); }
        GSYNC();
        { pg8::SchedStd S{(const char*)ACT, (const char*)(ws + WS_WDN), 64, 8, FF, G, blk};
          { pg8::Unit fu; for (int i = 0; S.next(i, fu); ++i) ffn_edge_fix(HALO, ACT, a.in[17] + (size_t)l * 3 * FF2, a.in[18] + (size_t)l * FF2, fu.pm, tid); }
          asm volatile("s_waitcnt vmcnt(0)" ::: "memory"); __syncthreads();
          pg8::EpiRes E{a.out, a.out, modl + 5 * DM, false};
          pg8::gemm_phase<pg8::EpiRes, pg8::SchedStd, true, true>(ldsL, FF, S, E); }
        if (l == 0) GSYNC();
    }
}

extern "C" void kernel_launch(void* const* d_in, const int* in_sizes, int n_in, void* d_out, int out_size, void* d_ws, size_t ws_size, hipStream_t stream) {
    static int grid = 0;
    if (grid == 0) {
        if (n_in != 20 || out_size != MTOK * DM || ws_size < WS_END) { fprintf(stderr, "kernel_launch: unexpected problem (n_in %d out %d ws %zu)\n", n_in, out_size, ws_size); grid = -1; return; }
        int dev = 0, cus = 0, per_cu = 0;
        if (hipGetDevice(&dev) != hipSuccess || hipDeviceGetAttribute(&cus, hipDeviceAttributeMultiprocessorCount, dev) != hipSuccess) { grid = -1; return; }
        if (hipFuncSetAttribute((const void*)fwd_mega, hipFuncAttributeMaxDynamicSharedMemorySize, LDS_BYTES) != hipSuccess) { fprintf(stderr, "hipFuncSetAttribute failed\n"); grid = -1; return; }
        if (hipOccupancyMaxActiveBlocksPerMultiprocessor(&per_cu, (const void*)fwd_mega, 512, LDS_BYTES) != hipSuccess || per_cu < 1) { fprintf(stderr, "occupancy query: %d\n", per_cu); }
        (void)hipGetLastError();
        grid = cus;
    }
    if (grid < 0) return;
    Args a{};
    for (int i = 0; i < 20; ++i) a.in[i] = (const float*)d_in[i];
    a.out = (float*)d_out; a.ws = (unsigned char*)d_ws;
    for (int j = 0; j < 16; ++j) a.invf[j] = std::pow(500000.0, -(double)(2 * j) / 32.0);
    void* args[] = {&a};
    if (hipMemsetAsync((char*)d_ws + WS_BAR, 0, XCD_BAR_WORDS * 4, stream) != hipSuccess) { fprintf(stderr, "kernel_launch: memset of the barrier words failed\n"); return; }
    hipError_t e = hipLaunchCooperativeKernel((const void*)fwd_mega, dim3(grid), dim3(512), args, LDS_BYTES, stream);
    if (e != hipSuccess) fprintf(stderr, "cooperative launch failed: %s (grid %d)\n", hipGetErrorString(e), grid);
}
```

```cpp
#include <hip/hip_runtime.h>
#include <hip/hip_cooperative_groups.h>
#include <cstdio>
#include <cstdint>
#include <cmath>
namespace cg = cooperative_groups;

#define LAS __attribute__((address_space(3)))
typedef unsigned short bf16_t;
typedef short bf16x8 __attribute__((ext_vector_type(8)));
typedef float f32x4 __attribute__((ext_vector_type(4)));
typedef float f32x16 __attribute__((ext_vector_type(16)));
typedef unsigned u32x4 __attribute__((ext_vector_type(4)));
typedef unsigned u32x2 __attribute__((ext_vector_type(2)));

constexpr int DM = 2048, NB = 4, SEQ = 4096, MTOK = NB * SEQ;
constexpr int INC = 8704, NMAIN = 7424, NVC = 1280, FF = 5632, FF2 = 11264, MODW = 12288;
constexpr int QKG_LD = NMAIN;
constexpr int VT_LD = MTOK + 128;
constexpr int C_QA = 0, C_KA = 1024, C_QB = 1280, C_KB = 2304, C_SA = 3328, C_SB = 5376;
constexpr float EPS = 1e-6f;
constexpr float LOG2E = 1.4426950408889634f;
constexpr float C2 = 0.08838834764831845f * 1.4426950408889634f;

constexpr size_t MiB = 1u << 20;
constexpr size_t WS_BAR = 0;
constexpr size_t WS_MOD = 1 * MiB;
constexpr size_t WS_NW = 1 * MiB + 512 * 1024;
constexpr size_t WS_ROPEC = 2 * MiB, WS_ROPES = 2 * MiB + 512 * 1024;
constexpr size_t WS_WIN = 4 * MiB;
constexpr size_t WS_WPA = 38 * MiB;
constexpr size_t WS_WPB = 42 * MiB;
constexpr size_t WS_WO = 46 * MiB;
constexpr size_t WS_WUP = 54 * MiB;
constexpr size_t WS_WDN = 98 * MiB;
constexpr size_t WS_H = 120 * MiB;
constexpr size_t WS_QKG = 184 * MiB;
constexpr size_t WS_VT = 416 * MiB;
constexpr size_t WS_OA = 457 * MiB;
constexpr size_t WS_OB = 489 * MiB;
constexpr size_t WS_T1 = 521 * MiB;
constexpr size_t WS_MRG = 585 * MiB;
constexpr size_t WS_HALO = 360 * MiB;
constexpr size_t WS_ACT = 184 * MiB;
constexpr size_t WS_END = 649 * MiB;

constexpr int LDS_BYTES = 147456;
constexpr int XL_OFF = 131072;
constexpr int MISC_OFF = 131072 + 8192;

__device__ __forceinline__ unsigned cvt_pk_bf16(float lo, float hi) { unsigned r; asm volatile("v_cvt_pk_bf16_f32 %0, %1, %2" : "=v"(r) : "v"(lo), "v"(hi)); return r; }
__device__ __forceinline__ float bf_lo(unsigned w) { return __uint_as_float(w << 16); }
__device__ __forceinline__ float bf_hi(unsigned w) { return __uint_as_float(w & 0xffff0000u); }
template <int M> __device__ __forceinline__ float swz_xor(float v) { return __builtin_bit_cast(float, __builtin_amdgcn_ds_swizzle(__builtin_bit_cast(int, v), (M << 10) | 0x1F)); }
__device__ __forceinline__ float wave_sum(float v) {
    v += swz_xor<1>(v); v += swz_xor<2>(v); v += swz_xor<4>(v); v += swz_xor<8>(v); v += swz_xor<16>(v);
    return v + __shfl_xor(v, 32);
}
__device__ __forceinline__ float sigmoidf_(float x) { return __builtin_amdgcn_rcpf(1.0f + __builtin_amdgcn_exp2f(-x * LOG2E)); }
__device__ __forceinline__ int clampi(int v, int lo, int hi) { return v < lo ? lo : (v > hi ? hi : v); }
__host__ __device__ __forceinline__ int ropeperm(int d) { return d < 16 ? 8 * (d >> 2) + (d & 3) : (d < 32 ? 8 * ((d - 16) >> 2) + 4 + (d & 3) : d); }

namespace pg8 {
constexpr int BM = 256, BK = 64, HALF = 128, HTB = HALF * BK * 2, STAGE_BYTES = 8 * HTB, NXCD = 8, WGM = 4;
__host__ __device__ __forceinline__ int lds_byte(int r, int c) { const int st = (r >> 4) * 2 + (c >> 5), rr = r & 15, cc = c & 31, ob = rr * 64 + cc * 2; return st * 1024 + (ob ^ (((ob >> 9) & 1) << 5)); }
__host__ __device__ __forceinline__ void stage_rc(int b, int& R, int& C) { const int st = b / 1024, sb = b % 1024, swz = sb ^ (((sb >> 9) & 1) << 5); R = (st >> 1) * 16 + swz / 64; C = (st & 1) * 32 + (swz % 64) / 2; }
__host__ __device__ __forceinline__ int perm32(int rho) { const int n = rho >> 4, i = rho & 15; return 8 * (i >> 2) + 4 * n + (i & 3); }

__device__ __forceinline__ void glds_s(unsigned voff, const void* base, unsigned ldsdst) {
    unsigned keep;
    asm volatile("s_mov_b32 %0, m0\n\ts_mov_b32 m0, %3\n\ts_nop 0\n\tglobal_load_lds_dwordx4 %1, %2\n\ts_mov_b32 m0, %0" : "=&s"(keep) : "v"(voff), "s"(base), "s"(ldsdst) : "memory");
}
struct Unit { int pm, pn, kind, pad; const char* A; const char* B; };

__device__ __forceinline__ void tile_of(int L, int nM, int nN, int& pm, int& pn) {
    const int nwg = nM * nN; int wgid = L;
    { const int q = nwg / NXCD, r = nwg % NXCD, xcd = wgid % NXCD, off = wgid / NXCD; wgid = (xcd < r ? xcd * (q + 1) : r * (q + 1) + (xcd - r) * q) + off; }
    const int nig = WGM * nN, gid = wgid / nig, fm = gid * WGM, gsz = (nM - fm) < WGM ? (nM - fm) : WGM;
    pm = fm + ((wgid % nig) % gsz); pn = (wgid % nig) / gsz;
}

template <class Epi, class Sched, bool ALIGN_EPI, bool SP2>
__device__ __forceinline__ void gemm_phase(LAS unsigned char* lds, const int K, const Sched& S, const Epi& E) {
    int tid = threadIdx.x; asm volatile("" : "+v"(tid));
    const int wid = __builtin_amdgcn_readfirstlane(tid >> 6), lane = tid & 63, wr = wid >> 2, wc = wid & 3, fr = lane & 15, fq = lane >> 4;
    const int nt = K / BK;
    unsigned voffA[2], voffB[2];
#pragma unroll
    for (int i = 0; i < 2; ++i) { int R, C; stage_rc(tid * 16 + i * 8192, R, C); const int Rb = Epi::PERM ? ((R & ~31) + perm32(R & 31)) : R;
        voffA[i] = (unsigned)(R * K + C) * 2u; voffB[i] = (unsigned)(Rb * K + C) * 2u; }
    const size_t kstep = (size_t)(BK * 2);
    const size_t hstep = (size_t)HALF * K * 2;
    const unsigned ldsw = (unsigned)wid * 1024u;
    const unsigned ldsbase = (unsigned)__builtin_amdgcn_readfirstlane((int)((unsigned)(uintptr_t)lds + ldsw));
    const int aoff = lds_byte(wr * 64 + fr, fq * 8), boff = lds_byte(wc * 32 + fr, fq * 8);
#define PG8_SA(b, h) (((b) * 2 + (h)) * HTB)
#define PG8_SB(b, h) ((4 + (b) * 2 + (h)) * HTB)
#define PG8_STAGE(bufoff, gbase, voff) do { _Pragma("unroll") for (int _i = 0; _i < 2; ++_i) \
        glds_s((voff)[_i], (const void*)(gbase), ldsbase + (unsigned)((bufoff) + _i * 8192)); } while (0)
#define PG8_LDA(dst, b, h) do { _Pragma("unroll") for (int m = 0; m < 4; ++m) _Pragma("unroll") for (int k = 0; k < 2; ++k) dst[m][k] = *(const LAS bf16x8*)(lds + PG8_SA(b, h) + aoff + m * 2048 + k * 1024); } while (0)
#define PG8_LDB(dst, b, h) do { _Pragma("unroll") for (int n = 0; n < 2; ++n) _Pragma("unroll") for (int k = 0; k < 2; ++k) dst[n][k] = *(const LAS bf16x8*)(lds + PG8_SB(b, h) + boff + n * 2048 + k * 1024); } while (0)
#define PG8_MMA(ai, bj, At, Bt) do { __builtin_amdgcn_s_setprio(1); _Pragma("unroll") for (int m = 0; m < 4; ++m) _Pragma("unroll") for (int n = 0; n < 2; ++n) _Pragma("unroll") for (int k = 0; k < 2; ++k) \
        acc[ai][bj][m][n] = __builtin_amdgcn_mfma_f32_16x16x32_bf16(Bt[n][k], At[m][k], acc[ai][bj][m][n], 0, 0, 0); __builtin_amdgcn_s_setprio(0); } while (0)
#define PG8_WAIT_V(n) asm volatile("s_waitcnt vmcnt(" #n ")" ::: "memory")
#define PG8_WAIT_L(n) asm volatile("s_waitcnt lgkmcnt(" #n ")" ::: "memory")
#define PG8_BAR __builtin_amdgcn_s_barrier()
#define PG8_SCHED __builtin_amdgcn_sched_barrier(0)
    Unit cur, nxt; int ui = 0;
    if (!S.next(0, cur)) return;
    f32x4 acc[2][2][4][2];
#pragma unroll
    for (int a = 0; a < 2; ++a)
#pragma unroll
        for (int b = 0; b < 2; ++b)
#pragma unroll
            for (int m = 0; m < 4; ++m)
#pragma unroll
                for (int n = 0; n < 2; ++n) acc[a][b][m][n] = (f32x4){0.f, 0.f, 0.f, 0.f};
    bf16x8 At[4][2], B0[2][2], B1[2][2];
    const char* cA = cur.A; const char* cB = cur.B;
    if constexpr (SP2) {
        PG8_STAGE(PG8_SB(0, 0), cB, voffB); PG8_STAGE(PG8_SB(0, 1), cB + hstep, voffB); PG8_STAGE(PG8_SA(0, 0), cA, voffA); PG8_STAGE(PG8_SA(0, 1), cA + hstep, voffA);
        if (wr == 1) PG8_BAR;
        PG8_WAIT_V(2); PG8_BAR;
        PG8_STAGE(PG8_SB(1, 0), cB + kstep, voffB); PG8_STAGE(PG8_SA(1, 0), cA + kstep, voffA); PG8_STAGE(PG8_SB(1, 1), cB + hstep + kstep, voffB);
        PG8_WAIT_V(6); PG8_BAR;
    } else {
        PG8_STAGE(PG8_SB(0, 0), cB, voffB); PG8_STAGE(PG8_SA(0, 0), cA, voffA); PG8_STAGE(PG8_SB(0, 1), cB + hstep, voffB); PG8_STAGE(PG8_SA(0, 1), cA + hstep, voffA);
        if (wr == 1) PG8_BAR;
        PG8_WAIT_V(4); PG8_BAR;
        PG8_STAGE(PG8_SB(1, 0), cB + kstep, voffB); PG8_STAGE(PG8_SA(1, 0), cA + kstep, voffA); PG8_STAGE(PG8_SB(1, 1), cB + hstep + kstep, voffB);
        PG8_WAIT_V(6); PG8_BAR;
    }
    for (;;) {
        const bool has_next = S.next(ui + 1, nxt);
        const char* nA = has_next ? nxt.A : cA; const char* nB = has_next ? nxt.B : cB;
        for (int t = 0; t < nt; t += 2) {
            const bool last = (t == nt - 2);
            const char* a1 = cA + (size_t)(t + 1) * kstep;
            const char* a2 = last ? nA : cA + (size_t)(t + 2) * kstep; const char* b2 = last ? nB : cB + (size_t)(t + 2) * kstep;
            const char* a3 = a2 + kstep; const char* b3 = b2 + kstep;
            if constexpr (SP2) {
            PG8_LDB(B0, 0, 0); PG8_LDB(B1, 0, 1); PG8_SCHED; PG8_LDA(At, 0, 0); PG8_STAGE(PG8_SA(1, 1), a1 + hstep, voffA);
            PG8_WAIT_V(8); PG8_WAIT_L(0); PG8_BAR; PG8_MMA(0, 0, At, B0); PG8_MMA(0, 1, At, B1); PG8_BAR; PG8_SCHED;
            PG8_LDA(At, 0, 1); PG8_STAGE(PG8_SB(0, 0), b2, voffB); PG8_STAGE(PG8_SB(0, 1), b2 + hstep, voffB); PG8_STAGE(PG8_SA(0, 0), a2, voffA);
            PG8_WAIT_V(8); PG8_WAIT_L(0); PG8_BAR; PG8_MMA(1, 0, At, B0); PG8_MMA(1, 1, At, B1); PG8_BAR; PG8_SCHED;
            PG8_LDB(B0, 1, 0); PG8_LDB(B1, 1, 1); PG8_SCHED; PG8_LDA(At, 1, 0); PG8_STAGE(PG8_SA(0, 1), a2 + hstep, voffA);
            PG8_WAIT_V(8); PG8_WAIT_L(0); PG8_BAR; PG8_MMA(0, 0, At, B0); PG8_MMA(0, 1, At, B1); PG8_BAR; PG8_SCHED;
            PG8_LDA(At, 1, 1); PG8_STAGE(PG8_SB(1, 0), b3, voffB); PG8_STAGE(PG8_SB(1, 1), b3 + hstep, voffB); PG8_STAGE(PG8_SA(1, 0), a3, voffA);
            PG8_WAIT_V(8); PG8_WAIT_L(0); PG8_BAR; PG8_MMA(1, 0, At, B0); PG8_MMA(1, 1, At, B1); PG8_BAR; PG8_SCHED;
            } else {
            PG8_LDB(B0, 0, 0); PG8_SCHED; PG8_LDA(At, 0, 0); PG8_STAGE(PG8_SA(1, 1), a1 + hstep, voffA);
            PG8_WAIT_L(8); PG8_BAR; PG8_WAIT_L(0); PG8_MMA(0, 0, At, B0); PG8_BAR; PG8_SCHED;
            PG8_LDB(B1, 0, 1); PG8_STAGE(PG8_SB(0, 0), b2, voffB);
            PG8_BAR; PG8_WAIT_L(0); PG8_MMA(0, 1, At, B1); PG8_BAR;
            PG8_LDA(At, 0, 1); PG8_STAGE(PG8_SA(0, 0), a2, voffA);
            PG8_BAR; PG8_WAIT_L(0); PG8_MMA(1, 0, At, B0); PG8_BAR; PG8_SCHED;
            PG8_STAGE(PG8_SB(0, 1), b2 + hstep, voffB);
            PG8_WAIT_V(6); PG8_BAR; PG8_MMA(1, 1, At, B1); PG8_BAR;
            PG8_LDB(B0, 1, 0); PG8_SCHED; PG8_LDA(At, 1, 0); PG8_STAGE(PG8_SA(0, 1), a2 + hstep, voffA);
            PG8_WAIT_L(8); PG8_BAR; PG8_WAIT_L(0); PG8_MMA(0, 0, At, B0); PG8_BAR; PG8_SCHED;
            PG8_LDB(B1, 1, 1); PG8_STAGE(PG8_SB(1, 0), b3, voffB);
            PG8_BAR; PG8_WAIT_L(0); PG8_MMA(0, 1, At, B1); PG8_BAR;
            PG8_LDA(At, 1, 1); PG8_STAGE(PG8_SA(1, 0), a3, voffA);
            PG8_BAR; PG8_WAIT_L(0); PG8_MMA(1, 0, At, B0); PG8_BAR; PG8_SCHED;
            PG8_STAGE(PG8_SB(1, 1), b3 + hstep, voffB);
            PG8_WAIT_V(6); PG8_BAR; PG8_MMA(1, 1, At, B1); PG8_BAR;
            }
        }
        if constexpr (ALIGN_EPI) { if (wr == 0) PG8_BAR; }
        E(acc, cur, wr, wc, fr, fq);
        PG8_WAIT_V(0);
        if (!has_next) break;
        if (!Epi::keep(cur)) {
#pragma unroll
        for (int a = 0; a < 2; ++a)
#pragma unroll
            for (int b = 0; b < 2; ++b)
#pragma unroll
                for (int m = 0; m < 4; ++m)
#pragma unroll
                    for (int n = 0; n < 2; ++n) acc[a][b][m][n] = (f32x4){0.f, 0.f, 0.f, 0.f};
        }
        cur = nxt; cA = nA; cB = nB; ++ui;
        if constexpr (ALIGN_EPI) { if (wr == 1) PG8_BAR; }
    }
    PG8_WAIT_V(0);
    if constexpr (!ALIGN_EPI) { if (wr == 0) PG8_BAR; }
    PG8_BAR;
#undef PG8_SA
#undef PG8_SB
#undef PG8_STAGE
#undef PG8_LDA
#undef PG8_LDB
#undef PG8_MMA
#undef PG8_WAIT_V
#undef PG8_WAIT_L
#undef PG8_BAR
#undef PG8_SCHED
}

struct SchedStd {
    const char* A; const char* Bt; int nM, nN, K, G, c;
    __device__ __forceinline__ bool next(int i, Unit& u) const {
        const int L = i * G + c; if (L >= nM * nN) return false;
        tile_of(L, nM, nN, u.pm, u.pn); u.kind = 0; u.pad = 0;
        u.A = A + (size_t)u.pm * 256 * K * 2; u.B = Bt + (size_t)u.pn * 256 * K * 2; return true;
    }
};
struct SchedIn {
    const char* H; const char* WinT; int G, c;
    __device__ __forceinline__ bool next(int i, Unit& u) const {
        constexpr int NMAINU = 64 * 29, NVU = 5 * 64; const size_t tb = (size_t)256 * DM * 2;
        const int L = i * G + c; u.pad = 0;
        if (L < NMAINU) { tile_of(L, 64, 29, u.pm, u.pn); u.kind = 0; u.A = H + u.pm * tb; u.B = WinT + u.pn * tb; return true; }
        const int L2 = L - NMAINU; if (L2 >= NVU) return false;
        u.kind = 1; { int tk, wt; tile_of(L2, 64, 5, tk, wt); u.pm = wt; u.pn = tk; }
        u.A = WinT + (size_t)(29 + u.pm) * tb; u.B = H + u.pn * tb; return true;
    }
};
struct SchedProj {
    const char* OA; const char* OB; const char* WA; const char* WB; int G, c;
    __device__ __forceinline__ bool next(int i, Unit& u) const {
        const int L = (i >> 1) * G + c; if (L >= 64 * 8) return false;
        tile_of(L, 64, 8, u.pm, u.pn); u.kind = i & 1; u.pad = 0; const size_t tb = (size_t)256 * 1024 * 2;
        u.A = ((i & 1) ? OB : OA) + u.pm * tb; u.B = ((i & 1) ? WB : WA) + u.pn * tb; return true;
    }
};

__device__ __forceinline__ u32x4 pack8(const f32x4 v0, const f32x4 v1) { u32x4 w; w.x = cvt_pk_bf16(v0[0], v0[1]); w.y = cvt_pk_bf16(v0[2], v0[3]); w.z = cvt_pk_bf16(v1[0], v1[1]); w.w = cvt_pk_bf16(v1[2], v1[3]); return w; }

struct EpiStore {
    static constexpr bool PERM = true; static __device__ __forceinline__ bool keep(const Unit&) { return false; }
    bf16_t* O; int ldc;
    __device__ __forceinline__ void operator()(const f32x4 (&acc)[2][2][4][2], const Unit& u, int wr, int wc, int fr, int fq) const {
        const int row0 = u.pm * BM + wr * 64 + fr, col0 = u.pn * BM + wc * 32 + 8 * fq;
#pragma unroll
        for (int ai = 0; ai < 2; ++ai)
#pragma unroll
            for (int m = 0; m < 4; ++m) { bf16_t* rowp = O + (size_t)(row0 + ai * HALF + m * 16) * ldc + col0;
#pragma unroll
                for (int bj = 0; bj < 2; ++bj) *(u32x4*)(rowp + bj * HALF) = pack8(acc[ai][bj][m][0], acc[ai][bj][m][1]); }
    }
};

struct EpiIn {
    static constexpr bool PERM = true; static __device__ __forceinline__ bool keep(const Unit&) { return false; }
    bf16_t* QKG; bf16_t* Vt; const float* nw; const float* ropec; const float* ropes; LAS float* xl;
    __device__ __forceinline__ void operator()(const f32x4 (&acc)[2][2][4][2], const Unit& u, int wr, int wc, int fr, int fq) const {
        const int row0 = u.pm * BM + wr * 64 + fr, col0 = u.pn * BM + wc * 32 + 8 * fq;
        if (u.kind == 1) {
#pragma unroll
            for (int ai = 0; ai < 2; ++ai)
#pragma unroll
                for (int m = 0; m < 4; ++m) { bf16_t* rowp = Vt + (size_t)(row0 + ai * HALF + m * 16) * VT_LD + col0;
#pragma unroll
                    for (int bj = 0; bj < 2; ++bj) *(u32x4*)(rowp + bj * HALF) = pack8(acc[ai][bj][m][0], acc[ai][bj][m][1]); }
            return;
        }
        const int pn = u.pn;
        if (pn >= 13) {
#pragma unroll
            for (int ai = 0; ai < 2; ++ai)
#pragma unroll
                for (int m = 0; m < 4; ++m) { bf16_t* rowp = QKG + (size_t)(row0 + ai * HALF + m * 16) * QKG_LD + col0;
#pragma unroll
                    for (int bj = 0; bj < 2; ++bj) { f32x4 v0 = acc[ai][bj][m][0], v1 = acc[ai][bj][m][1];
#pragma unroll
                        for (int e = 0; e < 4; ++e) { v0[e] = sigmoidf_(v0[e]); v1[e] = sigmoidf_(v1[e]); }
                        *(u32x4*)(rowp + bj * HALF) = pack8(v0, v1); } }
            return;
        }
        const bool isA = pn <= 4, isQ = (pn <= 3) || (pn >= 5 && pn <= 8);
        const float* gw = nw + (pn <= 3 ? 0 : (pn == 4 ? 128 : (pn <= 8 ? 256 : 384)));
#pragma unroll
        for (int ai = 0; ai < 2; ++ai)
#pragma unroll
            for (int m = 0; m < 4; ++m)
#pragma unroll
                for (int bj = 0; bj < 2; ++bj) { const f32x4 a = acc[ai][bj][m][0], b = acc[ai][bj][m][1];
                    float s = (a[0] * a[0] + a[1] * a[1]) + (a[2] * a[2] + a[3] * a[3]) + (b[0] * b[0] + b[1] * b[1]) + (b[2] * b[2] + b[3] * b[3]);
                    s += swz_xor<16>(s); s += __shfl_xor(s, 32);
                    if (fq == 0) xl[((ai * HALF + wr * 64 + m * 16 + fr) * 2 + bj) * 4 + wc] = s; }
        asm volatile("s_waitcnt lgkmcnt(0)" ::: "memory"); __builtin_amdgcn_s_barrier(); asm volatile("" ::: "memory");
        f32x4 g0, g1;
        if (isA && wc == 0) { g0 = *(const f32x4*)(gw + 4 * fq); g1 = *(const f32x4*)(gw + 16 + 4 * fq); }
        else { g0 = *(const f32x4*)(gw + wc * 32 + 8 * fq); g1 = *(const f32x4*)(gw + wc * 32 + 8 * fq + 4); }
        const float qs = isQ ? C2 : 1.0f;
#pragma unroll
        for (int ai = 0; ai < 2; ++ai)
#pragma unroll
            for (int m = 0; m < 4; ++m) { const int rl = ai * HALF + wr * 64 + m * 16 + fr; const int row = u.pm * BM + rl;
                bf16_t* rowp = QKG + (size_t)row * QKG_LD + col0;
                f32x4 cs = (f32x4){1.f, 1.f, 1.f, 1.f}, sn = (f32x4){0.f, 0.f, 0.f, 0.f};
                if (isA && wc == 0) { const int pos = row & (SEQ - 1); cs = *(const f32x4*)(ropec + pos * 16 + 4 * fq); sn = *(const f32x4*)(ropes + pos * 16 + 4 * fq); }
#pragma unroll
                for (int bj = 0; bj < 2; ++bj) {
                    const f32x4 ps = *(const LAS f32x4*)(xl + (rl * 2 + bj) * 4);
                    const float rstd = 1.0f / sqrtf(((ps[0] + ps[1]) + (ps[2] + ps[3])) * (1.0f / 128.0f) + EPS);
                    f32x4 v0 = acc[ai][bj][m][0] * rstd * g0, v1 = acc[ai][bj][m][1] * rstd * g1;
                    if (isA && wc == 0) { const f32x4 x1 = v0, x2 = v1; v0 = x1 * cs - x2 * sn; v1 = x2 * cs + x1 * sn; }
                    v0 = v0 * qs; v1 = v1 * qs;
                    *(u32x4*)(rowp + bj * HALF) = pack8(v0, v1); }
                asm volatile("" ::: "memory"); }
    }
};

struct EpiProj {
    static constexpr bool PERM = true; static __device__ __forceinline__ bool keep(const Unit& u) { return u.kind == 0; }
    bf16_t* MRG; const bf16_t* QKG;
    __device__ __forceinline__ void operator()(f32x4 (&acc)[2][2][4][2], const Unit& u, int wr, int wc, int fr, int fq) const {
        const int row0 = u.pm * BM + wr * 64 + fr, col0 = u.pn * BM + wc * 32 + 8 * fq;
#pragma unroll
        for (int ai = 0; ai < 2; ++ai)
#pragma unroll
            for (int m = 0; m < 4; ++m) { const size_t row = (size_t)(row0 + ai * HALF + m * 16);
#pragma unroll
                for (int bj = 0; bj < 2; ++bj) {
                    const u32x4 gb = *(const u32x4*)(QKG + row * QKG_LD + C_SB + col0 + bj * HALF);
                    f32x4 s0 = (f32x4){bf_lo(gb.x), bf_hi(gb.x), bf_lo(gb.y), bf_hi(gb.y)}, s1 = (f32x4){bf_lo(gb.z), bf_hi(gb.z), bf_lo(gb.w), bf_hi(gb.w)};
                    if (u.kind == 0) {
                        const u32x4 ga = *(const u32x4*)(QKG + row * QKG_LD + C_SA + col0 + bj * HALF);
#pragma unroll
                        for (int e = 0; e < 4; ++e) { s0[e] = __builtin_amdgcn_rcpf(s0[e]); s1[e] = __builtin_amdgcn_rcpf(s1[e]); }
                        s0 = s0 * (f32x4){bf_lo(ga.x), bf_hi(ga.x), bf_lo(ga.y), bf_hi(ga.y)}; s1 = s1 * (f32x4){bf_lo(ga.z), bf_hi(ga.z), bf_lo(ga.w), bf_hi(ga.w)};
                        acc[ai][bj][m][0] = acc[ai][bj][m][0] * s0; acc[ai][bj][m][1] = acc[ai][bj][m][1] * s1;
                    } else *(u32x4*)(MRG + row * DM + col0 + bj * HALF) = pack8(acc[ai][bj][m][0] * s0, acc[ai][bj][m][1] * s1); }
                if (m & 1) asm volatile("" ::: "memory"); }
    }
};

struct EpiRes {
    static constexpr bool PERM = false; static __device__ __forceinline__ bool keep(const Unit&) { return false; }
    const float* xin; float* xout; const float* gate; bool stream;
    __device__ __forceinline__ void operator()(const f32x4 (&acc)[2][2][4][2], const Unit& u, int wr, int wc, int fr, int fq) const {
        const int row0 = u.pm * BM + wr * 64 + fr, col0 = u.pn * BM + wc * 32 + 4 * fq; const int b = (u.pm * BM) >> 12;
        f32x4 gv[2][2];
#pragma unroll
        for (int bj = 0; bj < 2; ++bj)
#pragma unroll
            for (int n = 0; n < 2; ++n) gv[bj][n] = *(const f32x4*)(gate + b * MODW + col0 + bj * HALF + n * 16);
#pragma unroll
        for (int ai = 0; ai < 2; ++ai)
#pragma unroll
            for (int m = 0; m < 4; ++m) { const size_t off = (size_t)(row0 + ai * HALF + m * 16) * DM + col0;
#pragma unroll
                for (int bj = 0; bj < 2; ++bj)
#pragma unroll
                    for (int n = 0; n < 2; ++n) { const f32x4 bs = stream ? __builtin_nontemporal_load((const f32x4*)(xin + off + bj * HALF + n * 16)) : *(const f32x4*)(xin + off + bj * HALF + n * 16);
                        *(f32x4*)(xout + off + bj * HALF + n * 16) = bs + gv[bj][n] * acc[ai][bj][m][n]; }
                if (m & 1) asm volatile("" ::: "memory"); }
    }
};

__device__ __forceinline__ float dpp_ror1(float x) { return __builtin_bit_cast(float, __builtin_amdgcn_update_dpp(0, __builtin_bit_cast(int, x), 0x121, 0xF, 0xF, false)); }
__device__ __forceinline__ float dpp_rol1(float x) { return __builtin_bit_cast(float, __builtin_amdgcn_update_dpp(0, __builtin_bit_cast(int, x), 0x12F, 0xF, 0xF, false)); }
__device__ __forceinline__ f32x4 ror1v(const f32x4 v) { return (f32x4){dpp_ror1(v[0]), dpp_ror1(v[1]), dpp_ror1(v[2]), dpp_ror1(v[3])}; }
__device__ __forceinline__ f32x4 rol1v(const f32x4 v) { return (f32x4){dpp_rol1(v[0]), dpp_rol1(v[1]), dpp_rol1(v[2]), dpp_rol1(v[3])}; }

struct EpiUp {
    static constexpr bool PERM = true; static __device__ __forceinline__ bool keep(const Unit&) { return false; }
    bf16_t* ACT; float* HALO; const float* cw; const float* cb; LAS float* xl;
    __device__ __forceinline__ void operator()(const f32x4 (&acc)[2][2][4][2], const Unit& u, int wr, int wc, int fr, int fq) const {
        const int colw = 32 * wc + 8 * fq;
#pragma unroll
        for (int ai = 0; ai < 2; ++ai) { const int blk = 2 * ai + wr;
            if (fr == 0) {
#pragma unroll
                for (int bj = 0; bj < 2; ++bj)
#pragma unroll
                    for (int n = 0; n < 2; ++n) *(LAS f32x4*)(xl + (blk * 2 + 0) * 256 + 128 * bj + colw + 4 * n) = acc[ai][bj][0][n]; }
            if (fr == 15) {
#pragma unroll
                for (int bj = 0; bj < 2; ++bj)
#pragma unroll
                    for (int n = 0; n < 2; ++n) *(LAS f32x4*)(xl + (blk * 2 + 1) * 256 + 128 * bj + colw + 4 * n) = acc[ai][bj][3][n]; } }
        if (wr == 0 && fr < 2) { float* hp = HALO + ((size_t)(u.pm * 4 + fr)) * FF2 + 256 * u.pn + colw;
#pragma unroll
            for (int bj = 0; bj < 2; ++bj)
#pragma unroll
                for (int n = 0; n < 2; ++n) *(f32x4*)(hp + 128 * bj + 4 * n) = acc[0][bj][0][n]; }
        if (wr == 1 && fr >= 14) { float* hp = HALO + ((size_t)(u.pm * 4 + 2 + (fr - 14))) * FF2 + 256 * u.pn + colw;
#pragma unroll
            for (int bj = 0; bj < 2; ++bj)
#pragma unroll
                for (int n = 0; n < 2; ++n) *(f32x4*)(hp + 128 * bj + 4 * n) = acc[1][bj][3][n]; }
        asm volatile("s_waitcnt lgkmcnt(0)" ::: "memory"); __builtin_amdgcn_s_barrier(); asm volatile("" ::: "memory");
        const f32x4 z4 = (f32x4){0.f, 0.f, 0.f, 0.f};
#pragma unroll
        for (int n = 0; n < 2; ++n) {
            const int ch = 128 * u.pn + colw + 4 * n;
            const f32x4 w0g = *(const f32x4*)(cw + ch), w1g = *(const f32x4*)(cw + FF2 + ch), w2g = *(const f32x4*)(cw + 2 * FF2 + ch), bg = *(const f32x4*)(cb + ch);
            const f32x4 w0v = *(const f32x4*)(cw + FF + ch), w1v = *(const f32x4*)(cw + FF2 + FF + ch), w2v = *(const f32x4*)(cw + 2 * FF2 + FF + ch), bv = *(const f32x4*)(cb + FF + ch);
#pragma unroll
            for (int ai = 0; ai < 2; ++ai) { const int blk = 2 * ai + wr;
                const f32x4 hpg = blk > 0 ? *(const LAS f32x4*)(xl + ((blk - 1) * 2 + 1) * 256 + colw + 4 * n) : z4;
                const f32x4 hpv = blk > 0 ? *(const LAS f32x4*)(xl + ((blk - 1) * 2 + 1) * 256 + 128 + colw + 4 * n) : z4;
                const f32x4 hng = blk < 3 ? *(const LAS f32x4*)(xl + ((blk + 1) * 2 + 0) * 256 + colw + 4 * n) : z4;
                const f32x4 hnv = blk < 3 ? *(const LAS f32x4*)(xl + ((blk + 1) * 2 + 0) * 256 + 128 + colw + 4 * n) : z4;
#pragma unroll
                for (int m = 0; m < 4; ++m) {
                    const f32x4 cg_ = acc[ai][0][m][n], cv_ = acc[ai][1][m][n];
                    const f32x4 ug0 = m > 0 ? ror1v(acc[ai][0][m - 1][n]) : hpg, uv0 = m > 0 ? ror1v(acc[ai][1][m - 1][n]) : hpv;
                    const f32x4 dg0 = m < 3 ? rol1v(acc[ai][0][m + 1][n]) : hng, dv0 = m < 3 ? rol1v(acc[ai][1][m + 1][n]) : hnv;
                    const f32x4 ug1 = ror1v(cg_), uv1 = ror1v(cv_), dg1 = rol1v(cg_), dv1 = rol1v(cv_);
                    f32x4 ug, uv, dg, dv;
#pragma unroll
                    for (int e = 0; e < 4; ++e) { ug[e] = fr == 0 ? ug0[e] : ug1[e]; uv[e] = fr == 0 ? uv0[e] : uv1[e]; dg[e] = fr == 15 ? dg0[e] : dg1[e]; dv[e] = fr == 15 ? dv0[e] : dv1[e]; }
                    const f32x4 gc = w0g * ug + w1g * cg_ + w2g * dg + bg, vc = w0v * uv + w1v * cv_ + w2v * dv + bv;
                    f32x4 r;
#pragma unroll
                    for (int e = 0; e < 4; ++e) r[e] = gc[e] * sigmoidf_(gc[e]) * vc[e];
                    u32x2 w; w.x = cvt_pk_bf16(r[0], r[1]); w.y = cvt_pk_bf16(r[2], r[3]);
                    *(u32x2*)(ACT + (size_t)(u.pm * BM + ai * HALF + wr * 64 + m * 16 + fr) * FF + ch) = w;
                    asm volatile("" ::: "memory");
                }
            }
        }
    }
};
}

namespace att {
constexpr int KROW = 272, VROW = 272, KBUF = 128 * KROW, VBUF = 128 * VROW, OFF_V = 2 * KBUF, OFF_TAB = OFF_V + 2 * VBUF + 64;
__device__ __forceinline__ int pi32(int r) { return (r & 19) | ((r & 4) << 1) | ((r & 8) >> 1); }
constexpr float THR = 8.0f;
constexpr int TAB_SENT = 640;
#define ATT_STAGE_DECL() \
    const int st_row = tid >> 4, st_ch = tid & 15; \
    const bf16_t* kg = QKG + (size_t)(b * SEQ + kt0 + st_row) * QKG_LD + kcol0 + st_ch * 8; \
    const bf16_t* vg = Vt + (size_t)(vrow0 + st_row) * VT_LD + b * SEQ + kt0 + st_ch * 8; \
    u32x4 kr0 = *(const u32x4*)kg, kr1 = *(const u32x4*)(kg + (size_t)32 * QKG_LD), kr2 = *(const u32x4*)(kg + (size_t)64 * QKG_LD), kr3 = *(const u32x4*)(kg + (size_t)96 * QKG_LD); \
    u32x4 vr0 = *(const u32x4*)vg, vr1 = *(const u32x4*)(vg + (size_t)32 * VT_LD), vr2 = *(const u32x4*)(vg + (size_t)64 * VT_LD), vr3 = *(const u32x4*)(vg + (size_t)96 * VT_LD);
#define ATT_STAGE_STEP() \
        unsigned char* Kb = lds + (s & 1) * KBUF; unsigned char* Vb = lds + OFF_V + (s & 1) * VBUF; \
        { unsigned char* kd = Kb + st_row * KROW + st_ch * 16; unsigned char* vd = Vb + st_row * VROW + st_ch * 16; \
          *(u32x4*)kd = kr0; *(u32x4*)(kd + 32 * KROW) = kr1; *(u32x4*)(kd + 64 * KROW) = kr2; *(u32x4*)(kd + 96 * KROW) = kr3; \
          *(u32x4*)vd = vr0; *(u32x4*)(vd + 32 * VROW) = vr1; *(u32x4*)(vd + 64 * VROW) = vr2; *(u32x4*)(vd + 96 * VROW) = vr3; } \
        __syncthreads(); \
        if (s + 1 < nst) { const bf16_t* kg2 = kg + (size_t)(s + 1) * 128 * QKG_LD; const bf16_t* vg2 = vg + (s + 1) * 128; \
            kr0 = *(const u32x4*)kg2; kr1 = *(const u32x4*)(kg2 + (size_t)32 * QKG_LD); kr2 = *(const u32x4*)(kg2 + (size_t)64 * QKG_LD); kr3 = *(const u32x4*)(kg2 + (size_t)96 * QKG_LD); \
            vr0 = *(const u32x4*)vg2; vr1 = *(const u32x4*)(vg2 + (size_t)32 * VT_LD); vr2 = *(const u32x4*)(vg2 + (size_t)64 * VT_LD); vr3 = *(const u32x4*)(vg2 + (size_t)96 * VT_LD); }

__device__ __forceinline__ void attn_win(unsigned char* lds, const int unit, const bf16_t* __restrict__ QKG, const bf16_t* __restrict__ Vt, bf16_t* __restrict__ Oout, const float* __restrict__ sink) {
    int tid = threadIdx.x; asm volatile("" : "+v"(tid));
    const int lane = tid & 63, wid = __builtin_amdgcn_readfirstlane(tid >> 6), q31 = lane & 31, hi = lane >> 5;
    const int qc = unit & 63, g = (unit >> 6) & 1, b = unit >> 7;
    const int head = 4 * g + (wid >> 1), qbase = 64 * qc + 32 * (wid & 1), qtok = qbase + q31, kcol0 = C_KA + 128 * g, vrow0 = 128 * g;
    int lo = 64 * qc - 128, hiE = 64 * qc + 192; lo = lo < 0 ? 0 : lo; hiE = hiE > SEQ ? SEQ : hiE; const int kt0 = lo, nt = (hiE - lo) >> 6, nst = (nt + 1) >> 1;
    bf16x8 qf[8];
    { const bf16_t* qp = QKG + (size_t)(b * SEQ + qtok) * QKG_LD + C_QA + 128 * head + 8 * hi;
#pragma unroll
      for (int d0 = 0; d0 < 8; ++d0) qf[d0] = *(const bf16x8*)(qp + 16 * d0); }
    float m_run = sink[head] * LOG2E, l_run = hi == 0 ? 1.0f : 0.0f;
    f32x16 o[4];
#pragma unroll
    for (int i = 0; i < 4; ++i) o[i] = f32x16{};
    ATT_STAGE_DECL()
    const int ka_off = pi32(q31) * KROW + hi * 16, va_off = q31 * VROW + hi * 16;
    for (int s = 0; s < nst; ++s) {
        ATT_STAGE_STEP()
#pragma unroll
        for (int h = 0; h < 2; ++h) { const int it = 2 * s + h; if (it < nt) {
        const unsigned char* Kh = Kb + h * 64 * KROW; const unsigned char* Vh = Vb + h * 128;
        const int kpos0 = kt0 + 64 * it;
        f32x16 p0 = f32x16{}, p1 = f32x16{};
#pragma unroll
        for (int d0 = 0; d0 < 8; ++d0) {
            const bf16x8 k0 = *(const bf16x8*)(Kh + ka_off + d0 * 32), k1 = *(const bf16x8*)(Kh + ka_off + 32 * KROW + d0 * 32);
            p0 = __builtin_amdgcn_mfma_f32_32x32x16_bf16(k0, qf[d0], p0, 0, 0, 0);
            p1 = __builtin_amdgcn_mfma_f32_32x32x16_bf16(k1, qf[d0], p1, 0, 0, 0);
        }
        if ((kpos0 - (qbase + 31) < -128) || (kpos0 + 63 - qbase > 128)) {
#pragma unroll
            for (int r = 0; r < 16; ++r) { const int d0 = kpos0 + 16 * (r >> 3) + 8 * hi + (r & 7) - qtok, d1 = d0 + 32;
                if (d0 > 128 || d0 < -128) p0[r] = -INFINITY; if (d1 > 128 || d1 < -128) p1[r] = -INFINITY; }
        }
        float mx = fmaxf(p0[0], p1[0]);
#pragma unroll
        for (int r = 1; r < 16; ++r) mx = fmaxf(mx, fmaxf(p0[r], p1[r]));
        mx = fmaxf(mx, __shfl_xor(mx, 32));
        if (__any(mx > m_run + THR)) { const float mnew = fmaxf(m_run, mx), alpha = __builtin_amdgcn_exp2f(m_run - mnew); m_run = mnew; l_run *= alpha;
#pragma unroll
            for (int i = 0; i < 4; ++i)
#pragma unroll
                for (int r = 0; r < 16; ++r) o[i][r] *= alpha; }
        float ls = 0.f;
#pragma unroll
        for (int r = 0; r < 16; ++r) { p0[r] = __builtin_amdgcn_exp2f(p0[r] - m_run); p1[r] = __builtin_amdgcn_exp2f(p1[r] - m_run); ls += p0[r] + p1[r]; }
        l_run += ls;
        u32x4 pw[4];
        pw[0] = (u32x4){cvt_pk_bf16(p0[0], p0[1]), cvt_pk_bf16(p0[2], p0[3]), cvt_pk_bf16(p0[4], p0[5]), cvt_pk_bf16(p0[6], p0[7])};
        pw[1] = (u32x4){cvt_pk_bf16(p0[8], p0[9]), cvt_pk_bf16(p0[10], p0[11]), cvt_pk_bf16(p0[12], p0[13]), cvt_pk_bf16(p0[14], p0[15])};
        pw[2] = (u32x4){cvt_pk_bf16(p1[0], p1[1]), cvt_pk_bf16(p1[2], p1[3]), cvt_pk_bf16(p1[4], p1[5]), cvt_pk_bf16(p1[6], p1[7])};
        pw[3] = (u32x4){cvt_pk_bf16(p1[8], p1[9]), cvt_pk_bf16(p1[10], p1[11]), cvt_pk_bf16(p1[12], p1[13]), cvt_pk_bf16(p1[14], p1[15])};
#pragma unroll
        for (int t = 0; t < 4; ++t)
#pragma unroll
            for (int db = 0; db < 4; ++db) {
                const bf16x8 vf = *(const bf16x8*)(Vh + va_off + db * 32 * VROW + t * 32);
                o[db] = __builtin_amdgcn_mfma_f32_32x32x16_bf16(vf, __builtin_bit_cast(bf16x8, pw[t]), o[db], 0, 0, 0);
            }
        } }
    }
    const float lt = l_run + __shfl_xor(l_run, 32), inv = 1.0f / lt;
    bf16_t* op = Oout + (size_t)(b * SEQ + qtok) * 1024 + 128 * head + 4 * hi;
#pragma unroll
    for (int db = 0; db < 4; ++db)
#pragma unroll
        for (int rg = 0; rg < 4; ++rg) { u32x2 w; w.x = cvt_pk_bf16(o[db][4 * rg] * inv, o[db][4 * rg + 1] * inv); w.y = cvt_pk_bf16(o[db][4 * rg + 2] * inv, o[db][4 * rg + 3] * inv);
            *(u32x2*)(op + 32 * db + 8 * rg) = w; }
    __syncthreads();
}

__device__ __forceinline__ void attn_na(unsigned char* lds, const int unit, const bf16_t* __restrict__ QKG, const bf16_t* __restrict__ Vt, bf16_t* __restrict__ Oout, const float* __restrict__ btab) {
    int tid = threadIdx.x; asm volatile("" : "+v"(tid));
    const int lane = tid & 63, wid = __builtin_amdgcn_readfirstlane(tid >> 6), q31 = lane & 31, hi = lane >> 5;
    const int R = unit & 15, hd = (unit >> 4) & 7, b = unit >> 7;
    const int rp = wid >> 2, j = wid & 3, ra = 4 * R + 2 * rp, rq = ra + (q31 >> 4), ccol = 16 * j + (q31 & 15), qtok = 64 * rq + ccol;
    const int c0 = j == 0 ? 0 : (j == 1 ? 8 : (j == 2 ? 24 : 32));
    const int kcol0 = C_KB + 128 * hd, vrow0 = 256 + 128 * hd;
    const int r_lo = clampi(4 * R - 4, 0, 56), r_hi = clampi(4 * R - 1, 0, 56) + 8, kt0 = 64 * r_lo, nt = r_hi - r_lo, nst = (nt + 1) >> 1;
    const int wa_lo = clampi(ra - 4, 0, 56), wa_hi = clampi(ra - 3, 0, 56) + 8;
    const int rsq = clampi(rq - 4, 0, 56), cs = clampi(ccol - 8, 0, 48);
    bf16x8 qf[8];
    { const bf16_t* qp = QKG + (size_t)(b * SEQ + qtok) * QKG_LD + C_QB + 128 * hd + 8 * hi;
#pragma unroll
      for (int d0 = 0; d0 < 8; ++d0) qf[d0] = *(const bf16x8*)(qp + 16 * d0); }
    float* tab = (float*)(lds + OFF_TAB);
    for (int i = tid; i < TAB_SENT + 48; i += 512) tab[i] = (i >= 16 && i < 16 + 15 * 31) ? btab[hd * (15 * 31) + (i - 16)] * LOG2E : (i >= TAB_SENT - 16 ? -INFINITY : 0.0f);
    const int lanepart = c0 + 8 * hi - ccol + 15;
    float addmask[16];
#pragma unroll
    for (int r = 0; r < 16; ++r) { const int kc = c0 + 16 * (r >> 3) + 8 * hi + (r & 7); addmask[r] = (kc >= cs && kc < cs + 16) ? 0.0f : -INFINITY; }
    float m_run = -1e30f, l_run = 0.0f;
    f32x16 o[4];
#pragma unroll
    for (int i = 0; i < 4; ++i) o[i] = f32x16{};
    ATT_STAGE_DECL()
    const int ka_off = (c0 + pi32(q31)) * KROW + hi * 16, va_off = q31 * VROW + c0 * 2 + hi * 16;
    for (int s = 0; s < nst; ++s) {
        ATT_STAGE_STEP()
#pragma unroll
        for (int h = 0; h < 2; ++h) { const int it = 2 * s + h; const int krow = r_lo + it;
        if (it < nt && krow >= wa_lo && krow < wa_hi) {
            const unsigned char* Kh = Kb + h * 64 * KROW; const unsigned char* Vh = Vb + h * 128;
            f32x16 p0 = f32x16{};
#pragma unroll
            for (int d0 = 0; d0 < 8; ++d0) {
                const bf16x8 k0 = *(const bf16x8*)(Kh + ka_off + d0 * 32);
                p0 = __builtin_amdgcn_mfma_f32_32x32x16_bf16(k0, qf[d0], p0, 0, 0, 0);
            }
            const bool rowok = krow >= rsq && krow < rsq + 8;
            const float* trp = tab + (rowok ? (krow - rq + 7) * 31 + 16 : TAB_SENT) + lanepart;
#pragma unroll
            for (int r = 0; r < 16; ++r) p0[r] = (p0[r] + trp[16 * (r >> 3) + (r & 7)]) + addmask[r];
            float mx = p0[0];
#pragma unroll
            for (int r = 1; r < 16; ++r) mx = fmaxf(mx, p0[r]);
            mx = fmaxf(mx, __shfl_xor(mx, 32));
            if (__any(mx > m_run + THR)) { const float mnew = fmaxf(m_run, mx), alpha = __builtin_amdgcn_exp2f(m_run - mnew); m_run = mnew; l_run *= alpha;
#pragma unroll
                for (int i = 0; i < 4; ++i)
#pragma unroll
                    for (int r = 0; r < 16; ++r) o[i][r] *= alpha; }
            float ls = 0.f;
#pragma unroll
            for (int r = 0; r < 16; ++r) { p0[r] = __builtin_amdgcn_exp2f(p0[r] - m_run); ls += p0[r]; }
            l_run += ls;
            u32x4 pw[2];
            pw[0] = (u32x4){cvt_pk_bf16(p0[0], p0[1]), cvt_pk_bf16(p0[2], p0[3]), cvt_pk_bf16(p0[4], p0[5]), cvt_pk_bf16(p0[6], p0[7])};
            pw[1] = (u32x4){cvt_pk_bf16(p0[8], p0[9]), cvt_pk_bf16(p0[10], p0[11]), cvt_pk_bf16(p0[12], p0[13]), cvt_pk_bf16(p0[14], p0[15])};
#pragma unroll
            for (int t = 0; t < 2; ++t)
#pragma unroll
                for (int db = 0; db < 4; ++db) {
                    const bf16x8 vf = *(const bf16x8*)(Vh + va_off + db * 32 * VROW + t * 32);
                    o[db] = __builtin_amdgcn_mfma_f32_32x32x16_bf16(vf, __builtin_bit_cast(bf16x8, pw[t]), o[db], 0, 0, 0);
                }
        } }
    }
    const float lt = l_run + __shfl_xor(l_run, 32), inv = 1.0f / lt;
    bf16_t* op = Oout + (size_t)(b * SEQ + qtok) * 1024 + 128 * hd + 4 * hi;
#pragma unroll
    for (int db = 0; db < 4; ++db)
#pragma unroll
        for (int rg = 0; rg < 4; ++rg) { u32x2 w; w.x = cvt_pk_bf16(o[db][4 * rg] * inv, o[db][4 * rg + 1] * inv); w.y = cvt_pk_bf16(o[db][4 * rg + 2] * inv, o[db][4 * rg + 3] * inv);
            *(u32x2*)(op + 32 * db + 8 * rg) = w; }
    __syncthreads();
}
#undef ATT_STAGE_DECL
#undef ATT_STAGE_STEP
}


typedef __attribute__((address_space(1))) unsigned gu32;
#define XB_TMO      128
#define XB_XCNT(j)  (256  + 64 * (j))
#define XB_XSUB(j)  (1280 + 64 * (j))
#define XB_XGEN(j)  (2304 + 64 * (j))
#define XB_TOP      3328
#define XB_TOPGEN   3392
#define XCD_BAR_WORDS 3456
#define XB_SPIN_CAP (1u << 18)

__device__ __forceinline__ unsigned xb_ld(unsigned* p)              { return __hip_atomic_load(p, __ATOMIC_RELAXED, __HIP_MEMORY_SCOPE_AGENT); }
__device__ __forceinline__ unsigned xb_add(unsigned* p, unsigned v) { return __hip_atomic_fetch_add(p, v, __ATOMIC_RELAXED, __HIP_MEMORY_SCOPE_AGENT); }
__device__ __forceinline__ unsigned xb_xcc_id() { return (unsigned)__builtin_amdgcn_s_getreg((3 << 11) | 20) & 0xFu; }
#define XB_SPIN(cond, bar) do { unsigned _sp = 0; while (cond) { __builtin_amdgcn_s_sleep(1); \
    if ((++_sp & 255u) == 0u) { if (xb_ld(&(bar)[XB_TMO])) break; if (_sp > XB_SPIN_CAP) { atomicAdd(&(bar)[XB_TMO], 1u); break; } } } } while (0)

struct XcdBarrier {
    unsigned* bar; unsigned x;
    volatile LAS unsigned* st;
};

__device__ __forceinline__ XcdBarrier xcd_barrier_post(unsigned* bar, volatile LAS unsigned* st) {
    XcdBarrier b; b.bar = bar; b.x = xb_xcc_id(); b.st = st;
    if (threadIdx.x == 0) (void)xb_add(&bar[XB_XCNT(b.x)], 1u);
    return b;
}
__device__ __forceinline__ void xcd_barrier_complete(unsigned* bar, unsigned x, unsigned& nloc, unsigned& nx) {
    const unsigned G = gridDim.x * gridDim.y * gridDim.z;
    unsigned sum, cnt, mine, sp = 0u;
    for (;;) {
        sum = 0u; cnt = 0u; mine = 0u;
#pragma unroll
        for (unsigned j = 0; j < 16; ++j) { const unsigned c = xb_ld(&bar[XB_XCNT(j)]); sum += c; cnt += (c > 0u) ? 1u : 0u; mine = (j == x) ? c : mine; }
        if (sum == G) break;
        __builtin_amdgcn_s_sleep(1);
        if ((++sp & 255u) == 0u) { if (xb_ld(&bar[XB_TMO])) break; if (sp > XB_SPIN_CAP) { atomicAdd(&bar[XB_TMO], 1u); break; } }
    }
    nloc = mine > 0u ? mine : 1u; nx = cnt > 0u ? cnt : 1u;
}

__device__ __forceinline__ void xcd_barrier(const XcdBarrier& b) {
    asm volatile("s_waitcnt vmcnt(0)" ::: "memory");
    __syncthreads();
    if (threadIdx.x == 0) {
        unsigned* bar = b.bar;
        __builtin_amdgcn_s_waitcnt(0);
        unsigned nloc = b.st[0], nx = b.st[1];
        if (nloc == 0u) { xcd_barrier_complete(bar, b.x, nloc, nx); b.st[0] = nloc; b.st[1] = nx; }
        const unsigned old = xb_add(&bar[XB_XSUB(b.x)], 1u);
        const unsigned gen = old / nloc;
        if (old + 1u == (gen + 1u) * nloc) {
            __builtin_amdgcn_fence(__ATOMIC_RELEASE, "agent");
            asm volatile("s_waitcnt vmcnt(0)" ::: "memory");
            const unsigned og = xb_add(&bar[XB_TOP], 1u);
            const unsigned tg = og / nx;
            if (og + 1u == (tg + 1u) * nx) xb_add(&bar[XB_TOPGEN], 1u);
            else XB_SPIN(xb_ld(&bar[XB_TOPGEN]) == tg, bar);
            __builtin_amdgcn_fence(__ATOMIC_ACQUIRE, "agent");
            xb_add(&bar[XB_XGEN(b.x)], 1u);
            asm volatile("s_waitcnt vmcnt(0)" ::: "memory");
        } else {
            XB_SPIN(xb_ld(&bar[XB_XGEN(b.x)]) == gen, bar);
            __builtin_amdgcn_fence(__ATOMIC_ACQUIRE, "agent");
            asm volatile("s_waitcnt vmcnt(0)" ::: "memory");
        }
    }
    __syncthreads();
}

template <int MAP>
__device__ __forceinline__ int row_map(int n) {
    if (MAP == 1) {
        if (n < 1024) return (n & ~127) + ropeperm(n & 127);
        if (n < 1280) return (n & ~127) + ropeperm(n & 127);
        if (n < 1536) return 7424 + (n - 1280);
        if (n < 2560) return 1280 + (n - 1536);
        if (n < 3584) return 2304 + (n - 2560);
        if (n < 4608) return 7680 + (n - 3584);
        if (n < 6656) return 3328 + (n - 4608);
        return 5376 + (n - 6656);
    }
    if (MAP == 2) { const int c = n < FF ? n : n - FF; return 256 * (c >> 7) + (c & 127) + (n < FF ? 0 : 128); }
    return n;
}
template <int MAP>
__device__ __forceinline__ void transpose_item(const float* __restrict__ W, int K, int N, bf16_t* __restrict__ WT, float* scr, int item, int lane) {
    const int nblk = N / 32, kb = item / nblk, nb = item % nblk, k0 = 64 * kb, n0 = 32 * nb;
#pragma unroll 8
    for (int i = 0; i < 32; ++i) { const int kk = 2 * i + (lane >> 5); scr[kk * 33 + (lane & 31)] = __builtin_nontemporal_load(W + (size_t)(k0 + kk) * N + n0 + (lane & 31)); }
    asm volatile("s_waitcnt lgkmcnt(0)" ::: "memory");
    const int c = lane & 7;
#pragma unroll
    for (int j = 0; j < 4; ++j) { const int n = (lane >> 3) + 8 * j; const float* s = scr + (8 * c) * 33 + n;
        u32x4 o; o.x = cvt_pk_bf16(s[0 * 33], s[1 * 33]); o.y = cvt_pk_bf16(s[2 * 33], s[3 * 33]); o.z = cvt_pk_bf16(s[4 * 33], s[5 * 33]); o.w = cvt_pk_bf16(s[6 * 33], s[7 * 33]);
        if (MAP == 1) *(u32x4*)(WT + (size_t)row_map<MAP>(n0 + n) * K + k0 + 8 * c) = o;
        else __builtin_nontemporal_store(o, (u32x4*)(WT + (size_t)row_map<MAP>(n0 + n) * K + k0 + 8 * c)); }
    asm volatile("s_waitcnt lgkmcnt(0)" ::: "memory");
}

struct Args {
    const float* in[20]; float* out; unsigned char* ws; double invf[16];
};

__device__ __forceinline__ void convert_weights(const Args& a, int l, unsigned char* lds, int gw, int NGW, int wave, int lane) {
    { int t_ = threadIdx.x; asm volatile("" : "+v"(t_)); lane = t_ & 63; }
    float* scr = (float*)(lds + wave * 16384);
    unsigned char* ws = a.ws;
    const float* w_in = a.in[6] + (size_t)l * DM * INC; const float* w_pa = a.in[13] + (size_t)l * 1024 * DM; const float* w_pb = a.in[14] + (size_t)l * 1024 * DM;
    const float* w_o = a.in[15] + (size_t)l * DM * DM; const float* w_up = a.in[16] + (size_t)l * DM * FF2; const float* w_dn = a.in[19] + (size_t)l * FF * DM;
    constexpr int I_IN = (DM / 64) * (INC / 32), I_PA = (1024 / 64) * (DM / 32), I_O = (DM / 64) * (DM / 32), I_UP = (DM / 64) * (FF2 / 32), I_DN = (FF / 64) * (DM / 32);
    constexpr int NITEMS = I_IN + 2 * I_PA + I_O + I_UP + I_DN;
    for (int it = gw; it < NITEMS; it += NGW) {
        int r = it;
        if (r < I_IN) { transpose_item<1>(w_in, DM, INC, (bf16_t*)(ws + WS_WIN), scr, r, lane); continue; } r -= I_IN;
        if (r < I_PA) { transpose_item<0>(w_pa, 1024, DM, (bf16_t*)(ws + WS_WPA), scr, r, lane); continue; } r -= I_PA;
        if (r < I_PA) { transpose_item<0>(w_pb, 1024, DM, (bf16_t*)(ws + WS_WPB), scr, r, lane); continue; } r -= I_PA;
        if (r < I_O) { transpose_item<0>(w_o, DM, DM, (bf16_t*)(ws + WS_WO), scr, r, lane); continue; } r -= I_O;
        if (r < I_UP) { transpose_item<2>(w_up, DM, FF2, (bf16_t*)(ws + WS_WUP), scr, r, lane); continue; } r -= I_UP;
        transpose_item<0>(w_dn, FF, DM, (bf16_t*)(ws + WS_WDN), scr, r, lane);
    }
}

__device__ __forceinline__ void mod_gemv(const Args& a, unsigned char* lds, int blk, int G, int tid) {
    float* sc = (float*)lds;
    float* red = (float*)(lds + 32768);
    const float* c = a.in[1]; const float* ada_w = a.in[2]; const float* ada_b = a.in[3]; float* mod = (float*)(a.ws + WS_MOD);
    bool staged = false;
    for (int unit = blk; unit < 192; unit += G) {
        if (!staged) { for (int i = tid; i < NB * DM; i += 512) { const float v = c[i]; sc[i] = v / (1.0f + __expf(-v)); } staged = true; }
        __syncthreads();
        const int l = unit / 96, n0 = (unit % 96) * 128, tn = tid & 31, kg = tid >> 5;
        const float* wp = ada_w + ((size_t)l * DM + kg) * (6 * DM) + n0 + 4 * tn;
        f32x4 acc[4];
#pragma unroll
        for (int b = 0; b < 4; ++b) acc[b] = (f32x4){0.f, 0.f, 0.f, 0.f};
#pragma unroll 8
        for (int k = 0; k < DM / 16; ++k) { const f32x4 w = __builtin_nontemporal_load((const f32x4*)(wp + (size_t)k * 16 * (6 * DM))); const int kk = kg + 16 * k;
#pragma unroll
            for (int b = 0; b < 4; ++b) acc[b] += w * sc[b * DM + kk]; }
#pragma unroll
        for (int b = 0; b < 4; ++b) *(f32x4*)(red + (kg * 4 + b) * 128 + 4 * tn) = acc[b];
        __syncthreads();
        { const int b = tid >> 7, n = tid & 127; float s = 0.f;
#pragma unroll
          for (int g = 0; g < 16; ++g) s += red[(g * 4 + b) * 128 + n];
          mod[((size_t)l * NB + b) * MODW + n0 + n] = s + ada_b[(size_t)l * MODW + n0 + n]; }
        __syncthreads();
    }
}

__device__ __forceinline__ void rope_table(const Args& a, int gt, int GT) {
    float* rc = (float*)(a.ws + WS_ROPEC); float* rs = (float*)(a.ws + WS_ROPES);
    for (int i = gt; i < SEQ * 16; i += GT) {
        const int pos = i >> 4, j = i & 15;
        const double ang = (double)pos * a.invf[j];
        const double TWO_PI_HI = 6.283185307179586232, TWO_PI_LO = 2.4492935982947064e-16;
        const double n = rint(ang * 0.15915494309189534561);
        double r = fma(-n, TWO_PI_HI, ang); r = fma(-n, TWO_PI_LO, r);
        const double r2 = r * r;
        double sp = 1.0, cp = 1.0;
#pragma unroll
        for (int t = 16; t >= 1; --t) { sp = 1.0 - r2 * (1.0 / (double)((2 * t) * (2 * t + 1))) * sp; cp = 1.0 - r2 * (1.0 / (double)((2 * t - 1) * (2 * t))) * cp; }
        rc[i] = (float)cp; rs[i] = (float)(r * sp);
    }
}

__device__ __forceinline__ void norm_rows(const float* x, bf16_t* H, const float* g, const float* modl, int sh_off, int sc_off, int gw, int NGW, int lane, bool stream) {
    { int t_ = threadIdx.x; asm volatile("" : "+v"(t_)); lane = t_ & 63; }
    const int per_b = SEQ / NGW;
    if (NGW == 2048) {
        const int blk_ = gw >> 3, wv_ = gw & 7, x_ = blk_ & 7, i_ = blk_ >> 3, b = x_ >> 1, rbase = 2048 * x_ + 64 * i_ + 8 * wv_;
        f32x4 gp[8], sp[8];
#pragma unroll
        for (int j = 0; j < 8; ++j) { const int col = 4 * lane + 256 * j;
            gp[j] = *(const f32x4*)(g + col) * (*(const f32x4*)(modl + b * MODW + sc_off + col) + 1.0f); sp[j] = *(const f32x4*)(modl + b * MODW + sh_off + col); }
        for (int k = 0; k < 8; k += 2) {
            const int m0 = rbase + k, m1 = m0 + 1;
            const f32x4* x0 = (const f32x4*)(x + (size_t)m0 * DM) + lane; const f32x4* x1 = (const f32x4*)(x + (size_t)m1 * DM) + lane;
            f32x4 v0[8], v1[8]; float s0 = 0.f, s1 = 0.f;
            if (stream) { _Pragma("unroll") for (int j = 0; j < 8; ++j) { v0[j] = __builtin_nontemporal_load(x0 + 64 * j); v1[j] = __builtin_nontemporal_load(x1 + 64 * j); } }
            else { _Pragma("unroll") for (int j = 0; j < 8; ++j) { v0[j] = x0[64 * j]; v1[j] = x1[64 * j]; } }
#pragma unroll
            for (int j = 0; j < 8; ++j) { s0 += (v0[j][0] * v0[j][0] + v0[j][1] * v0[j][1]) + (v0[j][2] * v0[j][2] + v0[j][3] * v0[j][3]);
                                          s1 += (v1[j][0] * v1[j][0] + v1[j][1] * v1[j][1]) + (v1[j][2] * v1[j][2] + v1[j][3] * v1[j][3]); }
            const float r0 = 1.0f / sqrtf(wave_sum(s0) * (1.0f / DM) + EPS), r1 = 1.0f / sqrtf(wave_sum(s1) * (1.0f / DM) + EPS);
            u32x2* o0 = (u32x2*)(H + (size_t)m0 * DM) + lane; u32x2* o1 = (u32x2*)(H + (size_t)m1 * DM) + lane;
#pragma unroll
            for (int j = 0; j < 8; ++j) { const f32x4 a = (v0[j] * r0) * gp[j] + sp[j], c = (v1[j] * r1) * gp[j] + sp[j];
                u32x2 w; w.x = cvt_pk_bf16(a[0], a[1]); w.y = cvt_pk_bf16(a[2], a[3]); o0[64 * j] = w;
                u32x2 z; z.x = cvt_pk_bf16(c[0], c[1]); z.y = cvt_pk_bf16(c[2], c[3]); o1[64 * j] = z; }
        }
        return;
    }
    if (per_b * NGW == SEQ && (per_b & 1) == 0) {
        for (int b = 0; b < NB; ++b) {
            f32x4 gp[8], sp[8];
#pragma unroll
            for (int j = 0; j < 8; ++j) { const int col = 4 * lane + 256 * j;
                gp[j] = *(const f32x4*)(g + col) * (*(const f32x4*)(modl + b * MODW + sc_off + col) + 1.0f); sp[j] = *(const f32x4*)(modl + b * MODW + sh_off + col); }
            for (int k = 0; k < per_b; k += 2) {
                const int m0 = b * SEQ + gw + NGW * k, m1 = m0 + NGW;
                const f32x4* x0 = (const f32x4*)(x + (size_t)m0 * DM) + lane; const f32x4* x1 = (const f32x4*)(x + (size_t)m1 * DM) + lane;
                f32x4 v0[8], v1[8]; float s0 = 0.f, s1 = 0.f;
                if (stream) { _Pragma("unroll") for (int j = 0; j < 8; ++j) { v0[j] = __builtin_nontemporal_load(x0 + 64 * j); v1[j] = __builtin_nontemporal_load(x1 + 64 * j); } }
                else { _Pragma("unroll") for (int j = 0; j < 8; ++j) { v0[j] = x0[64 * j]; v1[j] = x1[64 * j]; } }
#pragma unroll
                for (int j = 0; j < 8; ++j) { s0 += (v0[j][0] * v0[j][0] + v0[j][1] * v0[j][1]) + (v0[j][2] * v0[j][2] + v0[j][3] * v0[j][3]);
                                              s1 += (v1[j][0] * v1[j][0] + v1[j][1] * v1[j][1]) + (v1[j][2] * v1[j][2] + v1[j][3] * v1[j][3]); }
                const float r0 = 1.0f / sqrtf(wave_sum(s0) * (1.0f / DM) + EPS), r1 = 1.0f / sqrtf(wave_sum(s1) * (1.0f / DM) + EPS);
                u32x2* o0 = (u32x2*)(H + (size_t)m0 * DM) + lane; u32x2* o1 = (u32x2*)(H + (size_t)m1 * DM) + lane;
#pragma unroll
                for (int j = 0; j < 8; ++j) { const f32x4 a = (v0[j] * r0) * gp[j] + sp[j], c = (v1[j] * r1) * gp[j] + sp[j];
                    u32x2 w; w.x = cvt_pk_bf16(a[0], a[1]); w.y = cvt_pk_bf16(a[2], a[3]); o0[64 * j] = w;
                    u32x2 z; z.x = cvt_pk_bf16(c[0], c[1]); z.y = cvt_pk_bf16(c[2], c[3]); o1[64 * j] = z; }
            }
        }
        return;
    }
    for (int m = gw; m < MTOK; m += NGW) {
        const int b = m >> 12;
        const f32x4* xr = (const f32x4*)(x + (size_t)m * DM) + lane;
        f32x4 v[8]; float s = 0.f;
#pragma unroll
        for (int j = 0; j < 8; ++j) { v[j] = xr[64 * j]; s += (v[j][0] * v[j][0] + v[j][1] * v[j][1]) + (v[j][2] * v[j][2] + v[j][3] * v[j][3]); }
        const float rstd = 1.0f / sqrtf(wave_sum(s) * (1.0f / DM) + EPS);
        u32x2* o8 = (u32x2*)(H + (size_t)m * DM) + lane;
#pragma unroll
        for (int j = 0; j < 8; ++j) { const int col = 4 * lane + 256 * j;
            const f32x4 gv = *(const f32x4*)(g + col), scv = *(const f32x4*)(modl + b * MODW + sc_off + col), shv = *(const f32x4*)(modl + b * MODW + sh_off + col);
            const f32x4 r = (v[j] * rstd * gv) * (scv + 1.0f) + shv;
            u32x2 w; w.x = cvt_pk_bf16(r[0], r[1]); w.y = cvt_pk_bf16(r[2], r[3]); o8[64 * j] = w; }
    }
}

__device__ __forceinline__ void ffn_edge_fix(const float* __restrict__ HALO, bf16_t* __restrict__ ACT, const float* __restrict__ cw, const float* __restrict__ cb, int pm, int tid) {
    tid = threadIdx.x; asm volatile("" : "+v"(tid));
    for (int it = tid; it < 2 * (FF / 4); it += 512) {
        const int which = it >= (FF / 4), c = 4 * (it - which * (FF / 4)), t = c >> 7, w = c & 127, col = 256 * t + w;
        const float* hp; const float* hc; const float* hn; bool hasp = true, hasn = true;
        if (!which) { hasp = (pm & 15) != 0; hp = HALO + (size_t)((pm - 1) * 4 + 3) * FF2; hc = HALO + (size_t)(pm * 4 + 0) * FF2; hn = HALO + (size_t)(pm * 4 + 1) * FF2; }
        else { hasn = (pm & 15) != 15; hp = HALO + (size_t)(pm * 4 + 2) * FF2; hc = HALO + (size_t)(pm * 4 + 3) * FF2; hn = HALO + (size_t)((pm + 1) * 4 + 0) * FF2; }
        const f32x4 z4 = (f32x4){0.f, 0.f, 0.f, 0.f};
        const f32x4 pg = hasp ? *(const f32x4*)(hp + col) : z4, pv = hasp ? *(const f32x4*)(hp + col + 128) : z4;
        const f32x4 cg_ = *(const f32x4*)(hc + col), cv_ = *(const f32x4*)(hc + col + 128);
        const f32x4 ng = hasn ? *(const f32x4*)(hn + col) : z4, nv = hasn ? *(const f32x4*)(hn + col + 128) : z4;
        const f32x4 gc = *(const f32x4*)(cw + c) * pg + *(const f32x4*)(cw + FF2 + c) * cg_ + *(const f32x4*)(cw + 2 * FF2 + c) * ng + *(const f32x4*)(cb + c);
        const f32x4 vc = *(const f32x4*)(cw + FF + c) * pv + *(const f32x4*)(cw + FF2 + FF + c) * cv_ + *(const f32x4*)(cw + 2 * FF2 + FF + c) * nv + *(const f32x4*)(cb + FF + c);
        f32x4 r;
#pragma unroll
        for (int e = 0; e < 4; ++e) r[e] = gc[e] * sigmoidf_(gc[e]) * vc[e];
        u32x2 o; o.x = cvt_pk_bf16(r[0], r[1]); o.y = cvt_pk_bf16(r[2], r[3]);
        *(u32x2*)(ACT + (size_t)(pm * 256 + (which ? 255 : 0)) * FF + c) = o;
    }
}

__global__ void __launch_bounds__(512, 2) fwd_mega(Args a) {
    extern __shared__ __attribute__((aligned(16))) unsigned char lds[];
    cg::grid_group grid = cg::this_grid();
    const int tid = threadIdx.x, lane = tid & 63, wave = __builtin_amdgcn_readfirstlane(tid >> 6);
    const int G = gridDim.x, blk = blockIdx.x;
    const int gw = blk * 8 + wave, NGW = G * 8;
    unsigned char* ws = a.ws;
    LAS unsigned char* ldsL = (LAS unsigned char*)lds;
    float* mod = (float*)(ws + WS_MOD);
    bf16_t* H = (bf16_t*)(ws + WS_H); bf16_t* QKG = (bf16_t*)(ws + WS_QKG); bf16_t* Vt = (bf16_t*)(ws + WS_VT);
    bf16_t* OA = (bf16_t*)(ws + WS_OA); bf16_t* OB = (bf16_t*)(ws + WS_OB); bf16_t* T1 = (bf16_t*)(ws + WS_T1); bf16_t* MRG = (bf16_t*)(ws + WS_MRG);
    float* HALO = (float*)(ws + WS_HALO); bf16_t* ACT = (bf16_t*)(ws + WS_ACT);

    if (tid < 2) ((volatile LAS unsigned*)(ldsL + MISC_OFF))[tid] = 0u;
    __syncthreads();
    const XcdBarrier xbar = xcd_barrier_post((unsigned*)(ws + WS_BAR), (volatile LAS unsigned*)(ldsL + MISC_OFF));
#define GSYNC() xcd_barrier(xbar)
    if (a.ws == nullptr) grid.sync();
    mod_gemv(a, lds, blk, G, tid);
    rope_table(a, blk * 512 + tid, G * 512);
    if (blk == G - 1 && tid < 256) { float* nwp = (float*)(ws + WS_NW); const int l_ = tid >> 7, d_ = tid & 127;
        nwp[l_ * 512 + d_] = a.in[7][tid]; nwp[l_ * 512 + 128 + d_] = a.in[8][tid]; nwp[l_ * 512 + 256 + d_] = a.in[9][tid]; nwp[l_ * 512 + 384 + d_] = a.in[10][tid]; }
    convert_weights(a, 0, lds, gw, NGW, wave, lane);
    GSYNC();

    for (int l = 0; l < 2; ++l) {
        const float* xin = l == 0 ? a.in[0] : a.out;
        const float* modl = mod + (size_t)l * NB * MODW;
        if (l == 1) convert_weights(a, 1, lds, gw, NGW, wave, lane);
        norm_rows(xin, H, a.in[4] + l * DM, modl, 0, DM, gw, NGW, lane, l == 0);
        GSYNC();
        { pg8::SchedIn S{(const char*)H, (const char*)(ws + WS_WIN), G, blk};
          pg8::EpiIn E{QKG, Vt, (const float*)(ws + WS_NW) + l * 512, (const float*)(ws + WS_ROPEC), (const float*)(ws + WS_ROPES), (LAS float*)(ldsL + XL_OFF)};
          pg8::gemm_phase<pg8::EpiIn, pg8::SchedIn, true, true>(ldsL, DM, S, E); }
        GSYNC();
        { const int vcu = (blk & 7) * 32 + (blk >> 3), xi = vcu & 31, xc = vcu >> 5; const bool xm = (G == 256);
#pragma nounroll
          for (int k = 0; k < (xm ? 4 : (1024 + G - 1) / G); ++k) {
              int u = blk + k * G;
              if (xm) u = k < 2 ? 2 * vcu + k : 512 + (4 * xc + 2 * (k - 2) + (xi >> 4)) * 16 + (xi & 15);
              if (u >= 1024) break;
              if (u < 512) att::attn_win(lds, u, QKG, Vt, OA, a.in[11] + l * 8);
              else att::attn_na(lds, u - 512, QKG, Vt, OB, a.in[12] + (size_t)l * 8 * 15 * 31);
          } }
        GSYNC();
        { pg8::SchedProj S{(const char*)OA, (const char*)OB, (const char*)(ws + WS_WPA), (const char*)(ws + WS_WPB), G, blk};
          pg8::EpiProj E{MRG, QKG};
          pg8::gemm_phase<pg8::EpiProj, pg8::SchedProj, true, true>(ldsL, 1024, S, E); }
        GSYNC();
        { pg8::SchedStd S{(const char*)MRG, (const char*)(ws + WS_WO), 64, 8, DM, G, blk};
          pg8::EpiRes E{xin, a.out, modl + 2 * DM, l == 0};
          pg8::gemm_phase<pg8::EpiRes, pg8::SchedStd, true, true>(ldsL, DM, S, E); }
        GSYNC();
        norm_rows(a.out, H, a.in[5] + l * DM, modl, 3 * DM, 4 * DM, gw, NGW, lane, false);
        GSYNC();
        { pg8::SchedStd S{(const char*)H, (const char*)(ws + WS_WUP), 64, 44, DM, G, blk};
          pg8::EpiUp E{ACT, HALO, a.in[17] + (size_t)l * 3 * FF2, a.in[18] + (size_t)l * FF2, (LAS float*)(ldsL + XL_OFF)};
          pg8::gemm_phase<pg8::EpiUp, pg8::SchedStd, true, true>(ldsL, DM, S, E); }
        GSYNC();
        { pg8::SchedStd S{(const char*)ACT, (const char*)(ws + WS_WDN), 64, 8, FF, G, blk};
          { pg8::Unit fu; for (int i = 0; S.next(i, fu); ++i) ffn_edge_fix(HALO, ACT, a.in[17] + (size_t)l * 3 * FF2, a.in[18] + (size_t)l * FF2, fu.pm, tid); }
          asm volatile("s_waitcnt vmcnt(0)" ::: "memory"); __syncthreads();
          pg8::EpiRes E{a.out, a.out, modl + 5 * DM, false};
          pg8::gemm_phase<pg8::EpiRes, pg8::SchedStd, true, true>(ldsL, FF, S, E); }
        if (l == 0) GSYNC();
    }
}

extern "C" void kernel_launch(void* const* d_in, const int* in_sizes, int n_in, void* d_out, int out_size, void* d_ws, size_t ws_size, hipStream_t stream) {
    static int grid = 0;
    if (grid == 0) {
        if (n_in != 20 || out_size != MTOK * DM || ws_size < WS_END) { fprintf(stderr, "kernel_launch: unexpected problem (n_in %d out %d ws %zu)\n", n_in, out_size, ws_size); grid = -1; return; }
        int dev = 0, cus = 0, per_cu = 0;
        if (hipGetDevice(&dev) != hipSuccess || hipDeviceGetAttribute(&cus, hipDeviceAttributeMultiprocessorCount, dev) != hipSuccess) { grid = -1; return; }
        if (hipFuncSetAttribute((const void*)fwd_mega, hipFuncAttributeMaxDynamicSharedMemorySize, LDS_BYTES) != hipSuccess) { fprintf(stderr, "hipFuncSetAttribute failed\n"); grid = -1; return; }
        if (hipOccupancyMaxActiveBlocksPerMultiprocessor(&per_cu, (const void*)fwd_mega, 512, LDS_BYTES) != hipSuccess || per_cu < 1) { fprintf(stderr, "occupancy query: %d\n", per_cu); }
        (void)hipGetLastError();
        grid = cus;
    }
    if (grid < 0) return;
    Args a{};
    for (int i = 0; i < 20; ++i) a.in[i] = (const float*)d_in[i];
    a.out = (float*)d_out; a.ws = (unsigned char*)d_ws;
    for (int j = 0; j < 16; ++j) a.invf[j] = std::pow(500000.0, -(double)(2 * j) / 32.0);
    void* args[] = {&a};
    if (hipMemsetAsync((char*)d_ws + WS_BAR, 0, XCD_BAR_WORDS * 4, stream) != hipSuccess) { fprintf(stderr, "kernel_launch: memset of the barrier words failed\n"); return; }
    hipError_t e = hipLaunchCooperativeKernel((const void*)fwd_mega, dim3(grid), dim3(512), args, LDS_BYTES, stream);
    if (e != hipSuccess) fprintf(stderr, "cooperative launch failed: %s (grid %d)\n", hipGetErrorString(e), grid);
}
```
